# Optimizing an MI355X kernel written in HIP

```python
import numpy as np
import jax
import jax.numpy as jnp
from jax import lax

D_MODEL = 2048
BATCH = 2
SEQ = 4096
DEPTH = 4
DEC_BATCH = 8
DEC_SEQ = 8
PAST_LEN = 16384
PAGE_SIZE = 128

N_MEM = 256
HEAD_DIM = 128
ATT_W = D_MODEL // 2
N_ATT_HEADS = ATT_W // HEAD_DIM
DIL_PATTERNS = ((128, 1), (512, 4), (2048, 16))
WIN = max(w for w, _ in DIL_PATTERNS)
N_BUCKETS = 32
MAX_DIST = WIN
CONV_CH = D_MODEL // 4
CONV_K = 31
X_W = D_MODEL // 4
N_X_HEADS = X_W // HEAD_DIM
MIX_W = ATT_W + CONV_CH + X_W
IN_SIZES = (ATT_W, ATT_W, ATT_W, ATT_W, CONV_CH, CONV_CH, CONV_CH, X_W, X_W)
IN_W = sum(IN_SIZES)
SPLIT_AT = tuple(int(s) for s in np.cumsum(IN_SIZES)[:-1])
Q_BLOCK = 128
EPS = 1e-6
NEG = -1e30
SCALE = HEAD_DIM ** -0.5

kernel_name = "hybrid_dilated_conv_memory_decoder_step"


def t5_bucket(dist):
    dist = np.asarray(dist)
    max_exact = N_BUCKETS // 2
    large = max_exact + (np.log(np.maximum(dist, 1) / max_exact)
                         / np.log(MAX_DIST / max_exact) * (N_BUCKETS - max_exact)).astype(np.int32)
    large = np.minimum(large, N_BUCKETS - 1)
    return np.where(dist < max_exact, dist, large).astype(np.int32)


def rms_norm(x, g):
    xf = x.astype(jnp.float32)
    y = xf * lax.rsqrt(jnp.mean(xf * xf, axis=-1, keepdims=True) + EPS)
    return (y * g.astype(jnp.float32)).astype(x.dtype)


def layer_norm(x, g, b):
    xf = x.astype(jnp.float32)
    mu = jnp.mean(xf, axis=-1, keepdims=True)
    var = jnp.mean(jnp.square(xf - mu), axis=-1, keepdims=True)
    y = (xf - mu) * lax.rsqrt(var + EPS) * g.astype(jnp.float32) + b.astype(jnp.float32)
    return y.astype(x.dtype)


def heads(t, n):
    return t.reshape(t.shape[:-1] + (n, HEAD_DIM))


def dilated_attention(q, k_src, v_src, base, lo, rel_bias):
    outs, lses = [], []
    for w, d in DIL_PATTERNS:
        offs = np.arange(w // d + 1) * d
        bias = rel_bias[t5_bucket(offs)].T.astype(jnp.float32)
        idx = base[:, None] - offs[None, :]
        valid = idx >= lo
        idx = jnp.maximum(idx, 0)
        kg = jnp.take(k_src, idx, axis=1)
        vg = jnp.take(v_src, idx, axis=1)
        logits = jnp.einsum('bqhd,bqjhd->bqhj', q, kg,
                            preferred_element_type=jnp.float32) * SCALE + bias
        logits = jnp.where(valid[None, :, None, :], logits, NEG)
        m = jnp.max(logits, axis=-1, keepdims=True)
        p = jnp.exp(logits - m)
        s = jnp.sum(p, axis=-1, keepdims=True)
        outs.append(jnp.einsum('bqhj,bqjhd->bqhd', p, vg.astype(jnp.float32)) / s)
        lses.append((m + jnp.log(s))[..., 0])
    wts = jax.nn.softmax(jnp.stack(lses, axis=0), axis=0)
    o = sum(wts[i][..., None] * outs[i] for i in range(len(DIL_PATTERNS)))
    return o.astype(q.dtype)


def dilated_attention_prompt(q, k, v, rel_bias):
    B, S, H, Dh = q.shape
    pad = jnp.zeros((B, WIN, H, Dh), k.dtype)
    kp = jnp.concatenate([pad, k], axis=1)
    vp = jnp.concatenate([pad, v], axis=1)
    base = WIN + jnp.arange(Q_BLOCK)

    def block(b):
        q0 = b * Q_BLOCK
        qb = lax.dynamic_slice_in_dim(q, q0, Q_BLOCK, axis=1)
        ks = lax.dynamic_slice_in_dim(kp, q0, WIN + Q_BLOCK, axis=1)
        vs = lax.dynamic_slice_in_dim(vp, q0, WIN + Q_BLOCK, axis=1)
        return dilated_attention(qb, ks, vs, base, WIN - q0, rel_bias)

    out = lax.map(block, jnp.arange(S // Q_BLOCK))
    return out.transpose(1, 0, 2, 3, 4).reshape(B, S, H, Dh)


def dilated_attention_sample(q, k_new, v_new, k_buf, v_buf, rel_bias):
    L = k_buf.shape[1]
    k_src = jnp.concatenate([k_buf, k_new], axis=1)
    v_src = jnp.concatenate([v_buf, v_new], axis=1)
    base = L + jnp.arange(q.shape[1])
    o = dilated_attention(q, k_src, v_src, base, 0, rel_bias)
    return o, k_src[:, -L:], v_src[:, -L:]


def causal_dwconv(u_ext, w, b):
    y = lax.conv_general_dilated(u_ext, w[:, None, :].astype(u_ext.dtype), window_strides=(1,),
                                 padding='VALID', dimension_numbers=('NWC', 'WIO', 'NWC'),
                                 feature_group_count=u_ext.shape[-1])
    return y + b


def conv_tail(c, g, b, w_pw2):
    return jax.nn.silu(layer_norm(c, g, b)) @ w_pw2


def cross_attention(q, mk, mv):
    logits = jnp.einsum('bthd,bmhd->bhtm', q, mk, preferred_element_type=jnp.float32) * SCALE
    p = jax.nn.softmax(logits, axis=-1)
    o = jnp.einsum('bhtm,bmhd->bthd', p, mv.astype(jnp.float32))
    return o.astype(q.dtype)


def mix_out(x, a, c, m, gate_att, gate_conv, gate_mem, w_out, g_post):
    y = jnp.concatenate([a * jax.nn.silu(gate_att), c * jax.nn.silu(gate_conv),
                         m * jax.nn.silu(gate_mem)], axis=-1) @ w_out
    return x + rms_norm(y, g_post)


def setup_inputs(seed: int = 0) -> dict:
    key = jax.random.key(seed)
    ks = jax.random.split(key, 20)
    n = jax.random.normal
    l_buf = min(WIN, PAST_LEN)
    return {
        'x_prompt': n(ks[0], (BATCH, SEQ, D_MODEL), jnp.float32),
        'x_sample': n(ks[1], (DEC_BATCH, DEC_SEQ, D_MODEL), jnp.float32),
        'mem_prompt': n(ks[2], (BATCH, N_MEM, D_MODEL), jnp.float32),
        'cache_attn_k': n(ks[3], (DEPTH, DEC_BATCH, l_buf, N_ATT_HEADS, HEAD_DIM), jnp.float32),
        'cache_attn_v': n(ks[4], (DEPTH, DEC_BATCH, l_buf, N_ATT_HEADS, HEAD_DIM), jnp.float32),
        'state_conv': 0.5 * n(ks[5], (DEPTH, DEC_BATCH, CONV_K - 1, CONV_CH), jnp.float32),
        'cache_mem_k': n(ks[6], (DEPTH, DEC_BATCH, N_MEM, N_X_HEADS, HEAD_DIM), jnp.float32),
        'cache_mem_v': n(ks[7], (DEPTH, DEC_BATCH, N_MEM, N_X_HEADS, HEAD_DIM), jnp.float32),
        'rel_bias': 0.1 * n(ks[8], (N_BUCKETS, N_ATT_HEADS), jnp.float32),
        'norm_pre_g': 1.0 + 0.02 * n(ks[9], (DEPTH, D_MODEL), jnp.float32),
        'w_in': n(ks[10], (DEPTH, D_MODEL, IN_W), jnp.float32) * D_MODEL ** -0.5,
        'w_dw': n(ks[11], (DEPTH, CONV_K, CONV_CH), jnp.float32) * CONV_K ** -0.5,
        'b_dw': 0.01 * n(ks[12], (DEPTH, CONV_CH), jnp.float32),
        'ln_conv_g': 1.0 + 0.02 * n(ks[13], (DEPTH, CONV_CH), jnp.float32),
        'ln_conv_b': 0.02 * n(ks[14], (DEPTH, CONV_CH), jnp.float32),
        'w_pw2': n(ks[15], (DEPTH, CONV_CH, CONV_CH), jnp.float32) * CONV_CH ** -0.5,
        'w_mem_kv': n(ks[16], (DEPTH, D_MODEL, 2 * X_W), jnp.float32) * D_MODEL ** -0.5,
        'w_out': n(ks[17], (DEPTH, MIX_W, D_MODEL), jnp.float32) * MIX_W ** -0.5,
        'norm_post_g': 1.0 + 0.02 * n(ks[18], (DEPTH, D_MODEL), jnp.float32),
    }


def reference(x_prompt, x_sample, mem_prompt, cache_attn_k, cache_attn_v, state_conv,
              cache_mem_k, cache_mem_v, rel_bias, norm_pre_g, w_in, w_dw, b_dw,
              ln_conv_g, ln_conv_b, w_pw2, w_mem_kv, w_out, norm_post_g):
    xp, xs = x_prompt, x_sample
    bp, s_len, _ = xp.shape
    bs, t_len, _ = xs.shape
    l_prompt = min(WIN, s_len)
    akp, avp, cvp, mkp, mvp, aks, avs, cvs = [], [], [], [], [], [], [], []
    for li in range(DEPTH):
        qa, ka, va, ga, uv, ug, gc, qm, gm = jnp.split(
            rms_norm(xp, norm_pre_g[li]) @ w_in[li], SPLIT_AT, axis=-1)
        qa, ka, va = heads(qa, N_ATT_HEADS), heads(ka, N_ATT_HEADS), heads(va, N_ATT_HEADS)
        a = dilated_attention_prompt(qa, ka, va, rel_bias).reshape(bp, s_len, ATT_W)
        u = uv * jax.nn.sigmoid(ug)
        u_ext = jnp.concatenate([jnp.zeros((bp, CONV_K - 1, CONV_CH), u.dtype), u], axis=1)
        c = conv_tail(causal_dwconv(u_ext, w_dw[li], b_dw[li]), ln_conv_g[li], ln_conv_b[li], w_pw2[li])
        mk, mv = jnp.split(mem_prompt @ w_mem_kv[li], 2, axis=-1)
        mk, mv = heads(mk, N_X_HEADS), heads(mv, N_X_HEADS)
        m = cross_attention(heads(qm, N_X_HEADS), mk, mv).reshape(bp, s_len, X_W)
        akp.append(ka[:, -l_prompt:])
        avp.append(va[:, -l_prompt:])
        cvp.append(u_ext[:, -(CONV_K - 1):])
        mkp.append(mk)
        mvp.append(mv)
        xp = mix_out(xp, a, c, m, ga, gc, gm, w_out[li], norm_post_g[li])

        qa, ka, va, ga, uv, ug, gc, qm, gm = jnp.split(
            rms_norm(xs, norm_pre_g[li]) @ w_in[li], SPLIT_AT, axis=-1)
        qa, ka, va = heads(qa, N_ATT_HEADS), heads(ka, N_ATT_HEADS), heads(va, N_ATT_HEADS)
        a, k_buf, v_buf = dilated_attention_sample(qa, ka, va, cache_attn_k[li], cache_attn_v[li], rel_bias)
        a = a.reshape(bs, t_len, ATT_W)
        u = uv * jax.nn.sigmoid(ug)
        u_ext = jnp.concatenate([state_conv[li].astype(u.dtype), u], axis=1)
        c = conv_tail(causal_dwconv(u_ext, w_dw[li], b_dw[li]), ln_conv_g[li], ln_conv_b[li], w_pw2[li])
        m = cross_attention(heads(qm, N_X_HEADS), cache_mem_k[li], cache_mem_v[li]).reshape(bs, t_len, X_W)
        aks.append(k_buf)
        avs.append(v_buf)
        cvs.append(u_ext[:, -(CONV_K - 1):])
        xs = mix_out(xs, a, c, m, ga, gc, gm, w_out[li], norm_post_g[li])

    return (xp, xs, jnp.stack(akp), jnp.stack(avp), jnp.stack(cvp), jnp.stack(mkp), jnp.stack(mvp),
            jnp.stack(aks), jnp.stack(avs), jnp.stack(cvs))
```

```cpp
#include <hip/hip_runtime.h>
#include <cstdio>
#include <cstdint>

constexpr int DM = 2048, BATCH = 2, SEQ = 4096, DEPTH = 4, DB = 8, DS = 8;
constexpr int NMEM = 256, HD = 128, ATT_W = 1024, NH = 8, WIN = 2048;
constexpr int CCH = 512, CK = 31, XW = 512, NXH = 4, MIXW = 2048, INW = 6656;
constexpr int MP = BATCH * SEQ;
constexpr int MS = DB * DS;
constexpr int MT = MP + MS;
constexpr float EPS = 1e-6f;
constexpr float SCALE = 0.08838834764831845f;
constexpr int C_Q = 0, C_K = 1024, C_V = 2048, C_GA = 3072, C_UV = 4096, C_UG = 4608, C_GC = 5120, C_QM = 5632, C_GM = 6144;

__device__ const unsigned char BUCKET[3][129] = {
 {0,1,2,3,4,5,6,7,8,9,10,11,12,13,14,15,16,16,16,16,16,16,17,17,17,17,17,17,17,17,18,18,18,18,18,18,18,18,18,18,19,19,19,19,19,19,19,19,19,19,19,19,19,19,20,20,20,20,20,20,20,20,20,20,20,20,20,20,20,20,20,20,20,21,21,21,21,21,21,21,21,21,21,21,21,21,21,21,21,21,21,21,21,21,21,21,21,21,21,22,22,22,22,22,22,22,22,22,22,22,22,22,22,22,22,22,22,22,22,22,22,22,22,22,22,22,22,22,22},
 {0,4,8,12,16,16,17,17,18,18,19,19,19,19,20,20,20,20,20,21,21,21,21,21,21,22,22,22,22,22,22,22,22,22,23,23,23,23,23,23,23,23,23,23,23,23,24,24,24,24,24,24,24,24,24,24,24,24,24,24,24,24,25,25,25,25,25,25,25,25,25,25,25,25,25,25,25,25,25,25,25,25,25,26,26,26,26,26,26,26,26,26,26,26,26,26,26,26,26,26,26,26,26,26,26,26,26,26,26,26,26,26,26,27,27,27,27,27,27,27,27,27,27,27,27,27,27,27,27},
 {0,16,18,19,20,21,21,22,22,23,23,23,24,24,24,24,25,25,25,25,25,26,26,26,26,26,26,26,26,27,27,27,27,27,27,27,27,27,27,28,28,28,28,28,28,28,28,28,28,28,28,28,29,29,29,29,29,29,29,29,29,29,29,29,29,29,29,29,29,29,30,30,30,30,30,30,30,30,30,30,30,30,30,30,30,30,30,30,30,30,30,30,30,30,30,31,31,31,31,31,31,31,31,31,31,31,31,31,31,31,31,31,31,31,31,31,31,31,31,31,31,31,31,31,31,31,31,31,31}};

__device__ __forceinline__ float wave_sum(float v) {
#pragma unroll
  for (int o = 1; o < 64; o <<= 1) v += __shfl_xor(v, o);
  return v;
}
__device__ __forceinline__ float silu(float x) { return x / (1.f + __expf(-x)); }
__device__ __forceinline__ float sigmoidf(float x) { return 1.f / (1.f + __expf(-x)); }

__global__ __launch_bounds__(256) void k_rms_pre(const float* __restrict__ x, const float* __restrict__ g, float* __restrict__ xn, int rows) {
  const int w = (blockIdx.x * 256 + threadIdx.x) >> 6, lane = threadIdx.x & 63;
  if (w >= rows) return;
  const float* xr = x + (size_t)w * DM; float s = 0.f;
  for (int k = lane; k < DM; k += 64) { float v = xr[k]; s += v * v; }
  s = wave_sum(s); const float rstd = rsqrtf(s / DM + EPS);
  for (int k = lane; k < DM; k += 64) xn[(size_t)w * DM + k] = xr[k] * rstd * g[k];
}

__global__ __launch_bounds__(256) void k_gemm(const float* __restrict__ A, const float* __restrict__ B, float* __restrict__ C, int M, int N, int K) {
  __shared__ float As[16][64 + 1]; __shared__ float Bs[16][64];
  const int tx = threadIdx.x & 15, ty = threadIdx.x >> 4, m0 = blockIdx.y * 64, n0 = blockIdx.x * 64;
  float acc[4][4] = {};
  for (int k0 = 0; k0 < K; k0 += 16) {
    for (int i = threadIdx.x; i < 64 * 16; i += 256) { int m = i >> 4, k = i & 15; As[k][m] = (m0 + m < M) ? A[(size_t)(m0 + m) * K + k0 + k] : 0.f; }
    for (int i = threadIdx.x; i < 16 * 64; i += 256) { int k = i >> 6, n = i & 63; Bs[k][n] = B[(size_t)(k0 + k) * N + n0 + n]; }
    __syncthreads();
#pragma unroll
    for (int k = 0; k < 16; ++k) {
      float a[4], b[4];
#pragma unroll
      for (int i = 0; i < 4; ++i) { a[i] = As[k][ty * 4 + i]; b[i] = Bs[k][tx * 4 + i]; }
#pragma unroll
      for (int i = 0; i < 4; ++i)
#pragma unroll
        for (int j = 0; j < 4; ++j) acc[i][j] += a[i] * b[j];
    }
    __syncthreads();
  }
  for (int i = 0; i < 4; ++i) { int m = m0 + ty * 4 + i; if (m < M) for (int j = 0; j < 4; ++j) C[(size_t)m * N + n0 + tx * 4 + j] = acc[i][j]; }
}

__global__ __launch_bounds__(256) void k_attn(const float* __restrict__ z, const float* __restrict__ ck, const float* __restrict__ cv, const float* __restrict__ rel_bias, float* __restrict__ a_out) {
  const int w = (blockIdx.x * 256 + threadIdx.x) >> 6, lane = threadIdx.x & 63;
  if (w >= MT * NH) return;
  const int row = w / NH, h = w % NH;
  const bool samp = row >= MP;
  int b, pos; if (!samp) { b = row / SEQ; pos = row % SEQ; } else { b = (row - MP) / DS; pos = WIN + (row - MP) % DS; }
  const float q0 = z[(size_t)row * INW + C_Q + h * HD + 2 * lane], q1 = z[(size_t)row * INW + C_Q + h * HD + 2 * lane + 1];
  float outs[3][2], lses[3];
  for (int p = 0; p < 3; ++p) {
    const int d = (p == 0) ? 1 : (p == 1) ? 4 : 16;
    float m = -3e38f, s = 0.f, o0 = 0.f, o1 = 0.f;
    for (int j = 0; j <= 128; ++j) {
      const int kp = pos - j * d; if (kp < 0) continue;
      const float* kr; const float* vr;
      if (!samp) { kr = z + (size_t)(b * SEQ + kp) * INW + C_K + h * HD; vr = z + (size_t)(b * SEQ + kp) * INW + C_V + h * HD; }
      else if (kp < WIN) { kr = ck + ((size_t)(b * WIN + kp) * NH + h) * HD; vr = cv + ((size_t)(b * WIN + kp) * NH + h) * HD; }
      else { kr = z + (size_t)(MP + b * DS + kp - WIN) * INW + C_K + h * HD; vr = z + (size_t)(MP + b * DS + kp - WIN) * INW + C_V + h * HD; }
      float dot = wave_sum(q0 * kr[2 * lane] + q1 * kr[2 * lane + 1]);
      const float logit = dot * SCALE + rel_bias[BUCKET[p][j] * NH + h];
      const float mn = fmaxf(m, logit), al = __expf(m - mn), pe = __expf(logit - mn);
      s = s * al + pe; o0 = o0 * al + pe * vr[2 * lane]; o1 = o1 * al + pe * vr[2 * lane + 1]; m = mn;
    }
    outs[p][0] = o0 / s; outs[p][1] = o1 / s; lses[p] = m + __logf(s);
  }
  const float mm = fmaxf(lses[0], fmaxf(lses[1], lses[2]));
  const float e0 = __expf(lses[0] - mm), e1 = __expf(lses[1] - mm), e2 = __expf(lses[2] - mm), inv = 1.f / (e0 + e1 + e2);
  a_out[(size_t)row * ATT_W + h * HD + 2 * lane] = (e0 * outs[0][0] + e1 * outs[1][0] + e2 * outs[2][0]) * inv;
  a_out[(size_t)row * ATT_W + h * HD + 2 * lane + 1] = (e0 * outs[0][1] + e1 * outs[1][1] + e2 * outs[2][1]) * inv;
}

__global__ __launch_bounds__(256) void k_glu(const float* __restrict__ z, float* __restrict__ u) {
  const size_t i = (size_t)blockIdx.x * 256 + threadIdx.x; if (i >= (size_t)MT * CCH) return;
  const int row = (int)(i / CCH), c = (int)(i % CCH);
  u[i] = z[(size_t)row * INW + C_UV + c] * sigmoidf(z[(size_t)row * INW + C_UG + c]);
}
__device__ __forceinline__ float u_ext_at(const float* u, const float* state, int row, int back  , int c) {
  if (row < MP) { const int b = row / SEQ, s = row % SEQ; const int sp = s - back; return sp >= 0 ? u[(size_t)(b * SEQ + sp) * CCH + c] : 0.f; }
  const int b = (row - MP) / DS, t = (row - MP) % DS; const int tp = t - back;
  if (tp >= 0) return u[(size_t)(MP + b * DS + tp) * CCH + c];
  return state[((size_t)b * (CK - 1) + (CK - 1 + tp)) * CCH + c];
}
__global__ __launch_bounds__(256) void k_conv(const float* __restrict__ u, const float* __restrict__ state, const float* __restrict__ wdw, const float* __restrict__ bdw,
                                              const float* __restrict__ lg, const float* __restrict__ lb, float* __restrict__ cact) {
  __shared__ float red[8];
  const int row = blockIdx.x, t = threadIdx.x;
  float v[2];
  for (int i = 0; i < 2; ++i) { const int c = t + 256 * i; float a = bdw[c];
    for (int k = 0; k < CK; ++k) a += wdw[k * CCH + c] * u_ext_at(u, state, row, CK - 1 - k, c);
    v[i] = a; }
  float s = wave_sum(v[0] + v[1]); if ((t & 63) == 0) red[t >> 6] = s; __syncthreads();
  const float mean = (red[0] + red[1] + red[2] + red[3]) / CCH; __syncthreads();
  const float d0 = v[0] - mean, d1 = v[1] - mean;
  s = wave_sum(d0 * d0 + d1 * d1); if ((t & 63) == 0) red[4 + (t >> 6)] = s; __syncthreads();
  const float rstd = rsqrtf((red[4] + red[5] + red[6] + red[7]) / CCH + EPS);
  for (int i = 0; i < 2; ++i) { const int c = t + 256 * i; const float y = (v[i] - mean) * rstd * lg[c] + lb[c]; cact[(size_t)row * CCH + c] = silu(y); }
}
__global__ __launch_bounds__(256) void k_conv_out(const float* __restrict__ u, const float* __restrict__ state, float* __restrict__ cvp, float* __restrict__ cvs) {
  const int i = blockIdx.x * 256 + threadIdx.x;
  if (i < BATCH * 30 * CCH) { const int b = i / (30 * CCH), r = (i / CCH) % 30, c = i % CCH; cvp[i] = u[(size_t)(b * SEQ + SEQ - 30 + r) * CCH + c]; }
  if (i < DB * 30 * CCH) { const int b = i / (30 * CCH), r = (i / CCH) % 30, c = i % CCH;
    cvs[i] = (r < 22) ? state[((size_t)b * 30 + r + 8) * CCH + c] : u[(size_t)(MP + b * DS + r - 22) * CCH + c]; }
}

__global__ __launch_bounds__(256) void k_cross(const float* __restrict__ z, const float* __restrict__ mkv, const float* __restrict__ cmk, const float* __restrict__ cmv, float* __restrict__ m_out) {
  const int w = (blockIdx.x * 256 + threadIdx.x) >> 6, lane = threadIdx.x & 63;
  if (w >= MT * NXH) return;
  const int row = w / NXH, h = w % NXH; const bool samp = row >= MP; const int b = samp ? (row - MP) / DS : row / SEQ;
  const float q0 = z[(size_t)row * INW + C_QM + h * HD + 2 * lane], q1 = z[(size_t)row * INW + C_QM + h * HD + 2 * lane + 1];
  float m = -3e38f, s = 0.f, o0 = 0.f, o1 = 0.f;
  for (int j = 0; j < NMEM; ++j) {
    const float* kr; const float* vr;
    if (!samp) { kr = mkv + (size_t)(b * NMEM + j) * 1024 + h * HD; vr = kr + 512; }
    else { kr = cmk + ((size_t)(b * NMEM + j) * NXH + h) * HD; vr = cmv + ((size_t)(b * NMEM + j) * NXH + h) * HD; }
    const float logit = wave_sum(q0 * kr[2 * lane] + q1 * kr[2 * lane + 1]) * SCALE;
    const float mn = fmaxf(m, logit), al = __expf(m - mn), pe = __expf(logit - mn);
    s = s * al + pe; o0 = o0 * al + pe * vr[2 * lane]; o1 = o1 * al + pe * vr[2 * lane + 1]; m = mn;
  }
  m_out[(size_t)row * XW + h * HD + 2 * lane] = o0 / s; m_out[(size_t)row * XW + h * HD + 2 * lane + 1] = o1 / s;
}

__global__ __launch_bounds__(256) void k_mix(const float* __restrict__ z, const float* __restrict__ a, const float* __restrict__ c, const float* __restrict__ m, float* __restrict__ mix) {
  const size_t i = (size_t)blockIdx.x * 256 + threadIdx.x; if (i >= (size_t)MT * MIXW) return;
  const int row = (int)(i / MIXW), col = (int)(i % MIXW); float v;
  if (col < 1024) v = a[(size_t)row * ATT_W + col] * silu(z[(size_t)row * INW + C_GA + col]);
  else if (col < 1536) v = c[(size_t)row * CCH + col - 1024] * silu(z[(size_t)row * INW + C_GC + col - 1024]);
  else v = m[(size_t)row * XW + col - 1536] * silu(z[(size_t)row * INW + C_GM + col - 1536]);
  mix[i] = v;
}
__global__ __launch_bounds__(256) void k_post(const float* x, const float* __restrict__ y, const float* __restrict__ g, float* xo, int rows) {
  const int w = (blockIdx.x * 256 + threadIdx.x) >> 6, lane = threadIdx.x & 63;
  if (w >= rows) return;
  const float* yr = y + (size_t)w * DM; float s = 0.f;
  for (int k = lane; k < DM; k += 64) { float v = yr[k]; s += v * v; }
  s = wave_sum(s); const float rstd = rsqrtf(s / DM + EPS);
  for (int k = lane; k < DM; k += 64) xo[(size_t)w * DM + k] = x[(size_t)w * DM + k] + yr[k] * rstd * g[k];
}
__global__ __launch_bounds__(256) void k_kv_out(const float* __restrict__ z, const float* __restrict__ ck, const float* __restrict__ cv, float* __restrict__ akp, float* __restrict__ avp, float* __restrict__ aks, float* __restrict__ avs) {
  const size_t i = (size_t)blockIdx.x * 256 + threadIdx.x;
  if (i < (size_t)BATCH * WIN * 1024) { const int b = (int)(i / ((size_t)WIN * 1024)), r = (int)((i / 1024) % WIN), c = (int)(i % 1024);
    akp[i] = z[(size_t)(b * SEQ + SEQ - WIN + r) * INW + C_K + c]; avp[i] = z[(size_t)(b * SEQ + SEQ - WIN + r) * INW + C_V + c]; }
  if (i < (size_t)DB * WIN * 1024) { const int b = (int)(i / ((size_t)WIN * 1024)), r = (int)((i / 1024) % WIN), c = (int)(i % 1024);
    if (r < WIN - DS) { aks[i] = ck[((size_t)b * WIN + r + DS) * 1024 + c]; avs[i] = cv[((size_t)b * WIN + r + DS) * 1024 + c]; }
    else { aks[i] = z[(size_t)(MP + b * DS + r - (WIN - DS)) * INW + C_K + c]; avs[i] = z[(size_t)(MP + b * DS + r - (WIN - DS)) * INW + C_V + c]; } }
}
__global__ __launch_bounds__(256) void k_mkv_out(const float* __restrict__ mkv, float* __restrict__ mko, float* __restrict__ mvo) {
  const int i = blockIdx.x * 256 + threadIdx.x; if (i >= 512 * 512) return;
  const int r = i / 512, c = i % 512; mko[i] = mkv[(size_t)r * 1024 + c]; mvo[i] = mkv[(size_t)r * 1024 + 512 + c];
}
__global__ __launch_bounds__(256) void k_copy(const float* __restrict__ a, float* __restrict__ b, size_t n) {
  for (size_t i = (size_t)blockIdx.x * 256 + threadIdx.x; i < n; i += (size_t)gridDim.x * 256) b[i] = a[i];
}

extern "C" void kernel_launch(void* const* d_in, const int* in_sizes, int n_in, void* d_out, int out_size, void* d_ws, size_t ws_size, hipStream_t stream) {
  const float* x_prompt = (const float*)d_in[0]; const float* x_sample = (const float*)d_in[1]; const float* mem_prompt = (const float*)d_in[2];
  const float* cache_k = (const float*)d_in[3]; const float* cache_v = (const float*)d_in[4]; const float* state_conv = (const float*)d_in[5];
  const float* cache_mk = (const float*)d_in[6]; const float* cache_mv = (const float*)d_in[7]; const float* rel_bias = (const float*)d_in[8];
  const float* g_pre = (const float*)d_in[9]; const float* w_in = (const float*)d_in[10]; const float* w_dw = (const float*)d_in[11];
  const float* b_dw = (const float*)d_in[12]; const float* ln_g = (const float*)d_in[13]; const float* ln_b = (const float*)d_in[14];
  const float* w_pw2 = (const float*)d_in[15]; const float* w_mkv = (const float*)d_in[16]; const float* w_out = (const float*)d_in[17];
  const float* g_post = (const float*)d_in[18];
  float* out = (float*)d_out;
  float* o_yp = out; float* o_ys = o_yp + (size_t)MP * DM; float* o_akp = o_ys + (size_t)MS * DM; float* o_avp = o_akp + (size_t)DEPTH * BATCH * WIN * 1024;
  float* o_cvp = o_avp + (size_t)DEPTH * BATCH * WIN * 1024; float* o_mkp = o_cvp + (size_t)DEPTH * BATCH * 30 * CCH; float* o_mvp = o_mkp + (size_t)DEPTH * 512 * 512;
  float* o_aks = o_mvp + (size_t)DEPTH * 512 * 512; float* o_avs = o_aks + (size_t)DEPTH * DB * WIN * 1024; float* o_cvs = o_avs + (size_t)DEPTH * DB * WIN * 1024;
  float* ws = (float*)d_ws; size_t off = 0;
  auto take = [&](size_t n) { float* p = ws + off; off += (n + 63) / 64 * 64; return p; };
  float* xcur = take((size_t)MT * DM); float* xn = take((size_t)MT * DM); float* z = take((size_t)MT * INW);
  float* a = take((size_t)MT * ATT_W); float* u = take((size_t)MT * CCH); float* cact = take((size_t)MT * CCH); float* cc = take((size_t)MT * CCH);
  float* mo = take((size_t)MT * XW); float* mix = take((size_t)MT * MIXW); float* y = take((size_t)MT * DM); float* mkv = take((size_t)512 * 1024);
  k_copy<<<2048, 256, 0, stream>>>(x_prompt, xcur, (size_t)MP * DM);
  k_copy<<<64, 256, 0, stream>>>(x_sample, xcur + (size_t)MP * DM, (size_t)MS * DM);
  for (int li = 0; li < DEPTH; ++li) {
    const float* ck = cache_k + (size_t)li * DB * WIN * 1024; const float* cv = cache_v + (size_t)li * DB * WIN * 1024;
    const float* st = state_conv + (size_t)li * DB * 30 * CCH;
    k_rms_pre<<<(MT * 64 + 255) / 256, 256, 0, stream>>>(xcur, g_pre + li * DM, xn, MT);
    k_gemm<<<dim3(INW / 64, (MT + 63) / 64), 256, 0, stream>>>(xn, w_in + (size_t)li * DM * INW, z, MT, INW, DM);
    k_kv_out<<<(int)(((size_t)DB * WIN * 1024 + 255) / 256), 256, 0, stream>>>(z, ck, cv, o_akp + (size_t)li * BATCH * WIN * 1024, o_avp + (size_t)li * BATCH * WIN * 1024,
                                                                    o_aks + (size_t)li * DB * WIN * 1024, o_avs + (size_t)li * DB * WIN * 1024);
    k_attn<<<(MT * NH * 64 + 255) / 256, 256, 0, stream>>>(z, ck, cv, rel_bias, a);
    k_glu<<<(MT * CCH + 255) / 256, 256, 0, stream>>>(z, u);
    k_conv_out<<<(DB * 30 * CCH + 255) / 256, 256, 0, stream>>>(u, st, o_cvp + (size_t)li * BATCH * 30 * CCH, o_cvs + (size_t)li * DB * 30 * CCH);
    k_conv<<<MT, 256, 0, stream>>>(u, st, w_dw + (size_t)li * CK * CCH, b_dw + li * CCH, ln_g + li * CCH, ln_b + li * CCH, cact);
    k_gemm<<<dim3(CCH / 64, (MT + 63) / 64), 256, 0, stream>>>(cact, w_pw2 + (size_t)li * CCH * CCH, cc, MT, CCH, CCH);
    k_gemm<<<dim3(1024 / 64, 512 / 64), 256, 0, stream>>>(mem_prompt, w_mkv + (size_t)li * DM * 1024, mkv, 512, 1024, DM);
    k_mkv_out<<<(512 * 512 + 255) / 256, 256, 0, stream>>>(mkv, o_mkp + (size_t)li * 512 * 512, o_mvp + (size_t)li * 512 * 512);
    k_cross<<<(MT * NXH * 64 + 255) / 256, 256, 0, stream>>>(z, mkv, cache_mk + (size_t)li * DB * NMEM * 512, cache_mv + (size_t)li * DB * NMEM * 512, mo);
    k_mix<<<(int)(((size_t)MT * MIXW + 255) / 256), 256, 0, stream>>>(z, a, cc, mo, mix);
    k_gemm<<<dim3(DM / 64, (MT + 63) / 64), 256, 0, stream>>>(mix, w_out + (size_t)li * MIXW * DM, y, MT, DM, MIXW);
    if (li < DEPTH - 1) k_post<<<(MT * 64 + 255) / 256, 256, 0, stream>>>(xcur, y, g_post + li * DM, xcur, MT);
    else { k_post<<<(MP * 64 + 255) / 256, 256, 0, stream>>>(xcur, y, g_post + li * DM, o_yp, MP);
           k_post<<<(MS * 64 + 255) / 256, 256, 0, stream>>>(xcur + (size_t)MP * DM, y + (size_t)MP * DM, g_post + li * DM, o_ys, MS); }
  }
}
```

```cpp
#include <hip/hip_runtime.h>
#include <hip/hip_cooperative_groups.h>
#include <cstdio>
#include <cstdint>
namespace cg = cooperative_groups;

constexpr int DM = 2048, BATCH = 2, SEQ = 4096, DEPTH = 4, DB = 8, DS = 8;
constexpr int NMEM = 256, HD = 128, ATT_W = 1024, NH = 8, WIN = 2048;
constexpr int CCH = 512, CK = 31, XW = 512, NXH = 4, MIXW = 2048, INW = 6656;
constexpr int MP = BATCH * SEQ;
constexpr int MS = DB * DS;
constexpr int MT = MP + MS;
constexpr int MPAD = 8448;
constexpr float EPS = 1e-6f;
constexpr float SCALE = 0.08838834764831845f, LOG2E = 1.4426950408889634f, QS = SCALE * LOG2E;
constexpr int NT = 512;
constexpr int LDS_BYTES = 155648;

__device__ const unsigned char BUCKET[3][129] = {
 {0,1,2,3,4,5,6,7,8,9,10,11,12,13,14,15,16,16,16,16,16,16,17,17,17,17,17,17,17,17,18,18,18,18,18,18,18,18,18,18,19,19,19,19,19,19,19,19,19,19,19,19,19,19,20,20,20,20,20,20,20,20,20,20,20,20,20,20,20,20,20,20,20,21,21,21,21,21,21,21,21,21,21,21,21,21,21,21,21,21,21,21,21,21,21,21,21,21,21,22,22,22,22,22,22,22,22,22,22,22,22,22,22,22,22,22,22,22,22,22,22,22,22,22,22,22,22,22,22},
 {0,4,8,12,16,16,17,17,18,18,19,19,19,19,20,20,20,20,20,21,21,21,21,21,21,22,22,22,22,22,22,22,22,22,23,23,23,23,23,23,23,23,23,23,23,23,24,24,24,24,24,24,24,24,24,24,24,24,24,24,24,24,25,25,25,25,25,25,25,25,25,25,25,25,25,25,25,25,25,25,25,25,25,26,26,26,26,26,26,26,26,26,26,26,26,26,26,26,26,26,26,26,26,26,26,26,26,26,26,26,26,26,26,27,27,27,27,27,27,27,27,27,27,27,27,27,27,27,27},
 {0,16,18,19,20,21,21,22,22,23,23,23,24,24,24,24,25,25,25,25,25,26,26,26,26,26,26,26,26,27,27,27,27,27,27,27,27,27,27,28,28,28,28,28,28,28,28,28,28,28,28,28,29,29,29,29,29,29,29,29,29,29,29,29,29,29,29,29,29,29,30,30,30,30,30,30,30,30,30,30,30,30,30,30,30,30,30,30,30,30,30,30,30,30,30,31,31,31,31,31,31,31,31,31,31,31,31,31,31,31,31,31,31,31,31,31,31,31,31,31,31,31,31,31,31,31,31,31,31}};

typedef unsigned short bf16_t;
typedef unsigned v4u __attribute__((ext_vector_type(4)));
typedef float f4 __attribute__((ext_vector_type(4)));
__device__ __forceinline__ unsigned f2bf(float f) { unsigned u = __builtin_bit_cast(unsigned, f); return (u + 0x7fffu + ((u >> 16) & 1u)) >> 16; }
__device__ __forceinline__ unsigned pk2(float lo, float hi) { unsigned r; asm("v_cvt_pk_bf16_f32 %0, %1, %2" : "=v"(r) : "v"(lo), "v"(hi)); return r; }
__device__ __forceinline__ float bf2f(unsigned short b) { return __builtin_bit_cast(float, (unsigned)b << 16); }
__device__ __forceinline__ float bflo(unsigned w) { return __builtin_bit_cast(float, w << 16); }
__device__ __forceinline__ float bfhi(unsigned w) { return __builtin_bit_cast(float, w & 0xffff0000u); }
__device__ __forceinline__ float wave_sum(float v) {
#pragma unroll
  for (int o = 1; o < 64; o <<= 1) v += __shfl_xor(v, o);
  return v;
}
__device__ __forceinline__ float sigmoidf(float x) { return __builtin_amdgcn_rcpf(1.f + __builtin_amdgcn_exp2f(-LOG2E * x)); }
__device__ __forceinline__ float silu(float x) { return x * sigmoidf(x); }

struct Params { const float* in[19]; float* out; unsigned char* ws; };
__device__ __forceinline__ unsigned long long karg(int k) {
  const volatile unsigned long long __attribute__((address_space(4)))* ka = (const volatile unsigned long long __attribute__((address_space(4)))*)__builtin_amdgcn_kernarg_segment_ptr();
  return ka[k];
}
#define GAS __attribute__((address_space(1)))
#define KIN(k) ((const float*)(const GAS float*)karg(k))
#define KOUT() ((float*)(GAS float*)karg(19))
#define KWS() ((unsigned char*)(GAS unsigned char*)karg(20))
enum { I_XP = 0, I_XS, I_MEM, I_CK, I_CV, I_ST, I_CMK, I_CMV, I_RB, I_GPRE, I_WIN, I_WDW, I_BDW, I_LNG, I_LNB, I_WPW, I_WMKV, I_WOUT, I_GPOST };
constexpr size_t O_YP = 0, O_YS = O_YP + (size_t)MP * DM, O_AKP = O_YS + (size_t)MS * DM, O_AVP = O_AKP + (size_t)DEPTH * BATCH * WIN * 1024,
  O_CVP = O_AVP + (size_t)DEPTH * BATCH * WIN * 1024, O_MKP = O_CVP + (size_t)DEPTH * BATCH * 30 * CCH, O_MVP = O_MKP + (size_t)DEPTH * 512 * 512,
  O_AKS = O_MVP + (size_t)DEPTH * 512 * 512, O_AVS = O_AKS + (size_t)DEPTH * DB * WIN * 1024, O_CVS = O_AVS + (size_t)DEPTH * DB * WIN * 1024;
constexpr size_t al256(size_t x) { return (x + 255) / 256 * 256; }
constexpr size_t KD_BYTES = al256((size_t)BATCH * NH * SEQ * HD * 2), PO_BYTES = al256((size_t)MPAD * 1024 * 2), PM_BYTES = al256((size_t)MPAD * NH * 4);
constexpr size_t W_WIN = 0, W_WMKV = W_WIN + (size_t)DEPTH * INW * DM * 2, W_WOUT = W_WMKV + al256((size_t)DEPTH * 1024 * DM * 2), W_WPW = W_WOUT + al256((size_t)DEPTH * DM * MIXW * 2),
  W_XCUR = W_WPW + al256((size_t)DEPTH * CCH * CCH * 2), W_XA = W_XCUR + al256((size_t)MT * DM * 4), W_MEMB = W_XA + (size_t)MPAD * DM * 2,
  W_QB = W_MEMB + al256((size_t)512 * DM * 2),
 W_KD = W_QB + al256((size_t)MPAD * 1024 * 2), W_VD = W_KD + 3 * al256((size_t)BATCH * NH * SEQ * HD * 2), W_GAB = W_VD + 3 * al256((size_t)BATCH * NH * SEQ * HD * 2),
  W_U = W_GAB + al256((size_t)MPAD * 1024 * 2), W_GCB = W_U + al256((size_t)MPAD * CCH * 4), W_QMB = W_GCB + al256((size_t)MPAD * 512 * 2), W_GMB = W_QMB + al256((size_t)MPAD * 512 * 2),
  W_MKB = W_GMB + al256((size_t)MPAD * 512 * 2), W_MVB = W_MKB + al256((size_t)DEPTH * 512 * 512 * 2), W_CACT = W_MVB + al256((size_t)DEPTH * 512 * 512 * 2),
  W_MIX = W_CACT + al256((size_t)MPAD * CCH * 2), W_Y = W_MIX + al256((size_t)MPAD * MIXW * 2), W_YSQ = W_Y + al256((size_t)MPAD * DM * 2),     W_PO = W_YSQ + al256((size_t)MPAD * 32 * 4), W_PM = W_PO + 2 * PO_BYTES, W_PL = W_PM + 2 * PM_BYTES,
  W_BAR = W_PL + 2 * PM_BYTES, W_CMKB = W_BAR + 16384, W_CMVB = W_CMKB + al256((size_t)DEPTH * DB * NMEM * 512 * 2), W_END = W_CMVB + al256((size_t)DEPTH * DB * NMEM * 512 * 2);
#define WSP(type, off) ((type*)(KWS() + (off)))
#define WIN_L(li) (WSP(bf16_t, W_WIN) + (size_t)(((li) + DEPTH - 1) % DEPTH) * INW * DM)
#define LAS __attribute__((address_space(3)))
constexpr int LDS_MISC = 153600;
__device__ __forceinline__ int lane_id_v() { int l; asm volatile("v_mbcnt_lo_u32_b32 %0, -1, 0\n\tv_mbcnt_hi_u32_b32 %0, -1, %0" : "=v"(l)); return l; }
#define LANE_ID() lane_id_v()
#define OPAQUE_IDS int ws_ = wave_s; asm volatile("" : "+s"(ws_)); int tid_ = ws_ * 64 + LANE_ID(); asm volatile("" : "+v"(tid_)); int bid_ = blockIdx.x; asm volatile("" : "+s"(bid_)); int nb_ = gridDim.x; asm volatile("" : "+s"(nb_));
#define GW   ((int)((bid_ * NT + tid_) >> 6))
#define NGW  ((int)(nb_ * (NT / 64)))
#define GT   ((size_t)bid_ * NT + tid_)
#define NGT  ((size_t)nb_ * NT)

namespace pg8 {
#define PG8_LAS __attribute__((address_space(3)))
typedef unsigned short bf16_t;
typedef short bf16x8 __attribute__((ext_vector_type(8)));
typedef float f32x4 __attribute__((ext_vector_type(4)));
typedef unsigned u32x4 __attribute__((ext_vector_type(4)));
constexpr int BM = 256, BK = 64, HALF = 128, HTB = HALF * BK * 2  , STAGE_BYTES = 8 * HTB, NXCD = 8, WGM = 8;

__host__ __device__ __forceinline__ int lds_byte(int r, int c) { const int st = (r >> 4) * 2 + (c >> 5), rr = r & 15, cc = c & 31, ob = rr * 64 + cc * 2; return st * 1024 + (ob ^ (((ob >> 9) & 1) << 5)); }
__host__ __device__ __forceinline__ void stage_rc(int b, int& R, int& C) { const int st = b / 1024, sb = b % 1024, swz = sb ^ (((sb >> 9) & 1) << 5); R = (st >> 1) * 16 + swz / 64; C = (st & 1) * 32 + (swz % 64) / 2; }
__host__ __device__ __forceinline__ int perm32(int rho) { const int n = rho >> 4, i = rho & 15; return 8 * (i >> 2) + 4 * n + (i & 3); }

struct Unit { int pm, pn; };
struct Gemm { const bf16_t* A; const bf16_t* Bt; int M, N, K; };

struct StaticOrder {
    int nM, nN, nwg, G, c, extra;
    __host__ __device__ void init(int M, int N, int G_, int c_, int extra_ = 0) { nM = M / BM; nN = N / BM; nwg = nM * nN; G = G_; c = c_; extra = extra_; }
    __host__ __device__ bool next(int i, Unit& u) const {
        const long L = (long)i * G + c; if (L >= nwg) { const int e = (int)(L - nwg); if (e >= extra) return false; u.pm = nM + (e & 1); u.pn = nN + (e >> 1); return true; }
        int wgid = (int)L; { const int q = nwg / NXCD, r = nwg % NXCD, xcd = wgid % NXCD, off = wgid / NXCD; wgid = (xcd < r ? xcd * (q + 1) : r * (q + 1) + (xcd - r) * q) + off; }
        const int nig = WGM * nN, gid = wgid / nig, fm = gid * WGM, gsz = (nM - fm) < WGM ? (nM - fm) : WGM;
        u.pm = fm + ((wgid % nig) % gsz); u.pn = (wgid % nig) / gsz; return true;
    }
    __device__ __forceinline__ void a_ready(const Unit&) const {}
    __device__ __forceinline__ void done(const Unit&) const {}
};

__device__ __forceinline__ unsigned cvt_pk_bf16(float lo, float hi) { unsigned r; asm volatile("v_cvt_pk_bf16_f32 %0, %1, %2" : "=v"(r) : "v"(lo), "v"(hi)); return r; }
typedef float f32x2 __attribute__((ext_vector_type(2)));
template <class Epi, class Sched, bool ALIGN_EPI = false, bool SP2 = false>
__device__ __forceinline__ void gemm_phase(PG8_LAS unsigned char* lds, const Gemm g, const Sched& S, const Epi& E, int wave_s) {
    int ws_ = wave_s; asm volatile("" : "+s"(ws_)); int tid_ = ws_ * 64 + lane_id_v(); asm volatile("" : "+v"(tid_));
    const int tid = tid_, wid = __builtin_amdgcn_readfirstlane(tid >> 6), lane = tid & 63, wr = wid >> 2, wc = wid & 3, fr = lane & 15, fq = lane >> 4;
    const int K = g.K, nt = K / BK;
    unsigned voffA[2], voffB[2];
#pragma unroll
    for (int i = 0; i < 2; ++i) { int R, C; stage_rc(tid * 16 + i * 8192, R, C); const int Rb = Epi::PERM ? ((R & ~31) + perm32(R & 31)) : R;
        voffA[i] = (unsigned)(R * K + C) * 2u; voffB[i] = (unsigned)(Rb * K + C) * 2u; }
    const size_t kstep = (size_t)(BK * 2);
    const size_t hstep = (size_t)HALF * K * 2;
    const size_t tstep = 2 * hstep;
    const unsigned ldsw = (unsigned)wid * 1024u;
    const int aoff = lds_byte(wr * 64 + fr, fq * 8), boff = lds_byte(wc * 32 + fr, fq * 8);
#define PG8_SA(b, h) (((b) * 2 + (h)) * HTB)
#define PG8_SB(b, h) ((4 + (b) * 2 + (h)) * HTB)
#define PG8_STAGE(bufoff, gbase, voff) do { _Pragma("unroll") for (int _i = 0; _i < 2; ++_i) \
        __builtin_amdgcn_global_load_lds((const unsigned*)((const char*)(gbase) + (voff)[_i]), (PG8_LAS unsigned*)(lds + (bufoff) + ldsw + _i * 8192), 16, 0, 0); } while (0)
#define PG8_LDA(dst, b, h) do { _Pragma("unroll") for (int m = 0; m < 4; ++m) _Pragma("unroll") for (int k = 0; k < 2; ++k) dst[m][k] = *(const PG8_LAS bf16x8*)(lds + PG8_SA(b, h) + aoff + m * 2048 + k * 1024); } while (0)
#define PG8_LDB(dst, b, h) do { _Pragma("unroll") for (int n = 0; n < 2; ++n) _Pragma("unroll") for (int k = 0; k < 2; ++k) dst[n][k] = *(const PG8_LAS bf16x8*)(lds + PG8_SB(b, h) + boff + n * 2048 + k * 1024); } while (0)
#define PG8_MMA(ai, bj, At, Bt) do { __builtin_amdgcn_s_setprio(1); _Pragma("unroll") for (int m = 0; m < 4; ++m) _Pragma("unroll") for (int n = 0; n < 2; ++n) _Pragma("unroll") for (int k = 0; k < 2; ++k) \
        acc[ai][bj][m][n] = __builtin_amdgcn_mfma_f32_16x16x32_bf16(Bt[n][k], At[m][k], acc[ai][bj][m][n], 0, 0, 0); __builtin_amdgcn_s_setprio(0); } while (0)
#define PG8_WAIT_V(n) asm volatile("s_waitcnt vmcnt(" #n ")" ::: "memory")
#define PG8_WAIT_L(n) asm volatile("s_waitcnt lgkmcnt(" #n ")" ::: "memory")
#define PG8_BAR __builtin_amdgcn_s_barrier()
#define PG8_SCHED __builtin_amdgcn_sched_barrier(0)
    Unit cur, nxt; int ui = 0;
    if (!S.next(0, cur)) return;
    f32x4 acc[2][2][4][2];
#pragma unroll
    for (int a = 0; a < 2; ++a)
#pragma unroll
        for (int b = 0; b < 2; ++b)
#pragma unroll
            for (int m = 0; m < 4; ++m)
#pragma unroll
                for (int n = 0; n < 2; ++n) acc[a][b][m][n] = (f32x4){0.f, 0.f, 0.f, 0.f};
    bf16x8 At[4][2], B0[2][2], B1[2][2];
    const char* cA = (const char*)g.A + (size_t)cur.pm * tstep; const char* cB = (const char*)g.Bt + (size_t)cur.pn * tstep;
    S.a_ready(cur);
    if constexpr (SP2) {
        PG8_STAGE(PG8_SB(0, 0), cB, voffB); PG8_STAGE(PG8_SB(0, 1), cB + hstep, voffB); PG8_STAGE(PG8_SA(0, 0), cA, voffA); PG8_STAGE(PG8_SA(0, 1), cA + hstep, voffA);
        if (wr == 1) PG8_BAR;
        PG8_WAIT_V(2); PG8_BAR;
        PG8_STAGE(PG8_SB(1, 0), cB + kstep, voffB); PG8_STAGE(PG8_SA(1, 0), cA + kstep, voffA); PG8_STAGE(PG8_SB(1, 1), cB + hstep + kstep, voffB);
        PG8_WAIT_V(6); PG8_BAR;
    } else {
        PG8_STAGE(PG8_SB(0, 0), cB, voffB); PG8_STAGE(PG8_SA(0, 0), cA, voffA); PG8_STAGE(PG8_SB(0, 1), cB + hstep, voffB); PG8_STAGE(PG8_SA(0, 1), cA + hstep, voffA);
        if (wr == 1) PG8_BAR;
        PG8_WAIT_V(4); PG8_BAR;
        PG8_STAGE(PG8_SB(1, 0), cB + kstep, voffB); PG8_STAGE(PG8_SA(1, 0), cA + kstep, voffA); PG8_STAGE(PG8_SB(1, 1), cB + hstep + kstep, voffB);
        PG8_WAIT_V(6); PG8_BAR;
    }
    for (;;) {
        const bool has_next = S.next(ui + 1, nxt);
        const char* nA = has_next ? (const char*)g.A + (size_t)nxt.pm * tstep : cA; const char* nB = has_next ? (const char*)g.Bt + (size_t)nxt.pn * tstep : cB;
        for (int t = 0; t < nt; t += 2) {
            const bool last = (t == nt - 2);
            const char* a1 = cA + (size_t)(t + 1) * kstep;
            const char* a2 = last ? nA : cA + (size_t)(t + 2) * kstep; const char* b2 = last ? nB : cB + (size_t)(t + 2) * kstep;
            const char* a3 = a2 + kstep; const char* b3 = b2 + kstep;
            if (last && has_next) S.a_ready(nxt);
            if constexpr (SP2) {
            PG8_LDB(B0, 0, 0); PG8_LDB(B1, 0, 1); PG8_SCHED; PG8_LDA(At, 0, 0); PG8_STAGE(PG8_SA(1, 1), a1 + hstep, voffA);
            PG8_WAIT_V(8); PG8_WAIT_L(0); PG8_BAR; PG8_MMA(0, 0, At, B0); PG8_MMA(0, 1, At, B1); PG8_BAR; PG8_SCHED;
            PG8_LDA(At, 0, 1); PG8_STAGE(PG8_SB(0, 0), b2, voffB); PG8_STAGE(PG8_SB(0, 1), b2 + hstep, voffB); PG8_STAGE(PG8_SA(0, 0), a2, voffA);
            PG8_WAIT_V(8); PG8_WAIT_L(0); PG8_BAR; PG8_MMA(1, 0, At, B0); PG8_MMA(1, 1, At, B1); PG8_BAR; PG8_SCHED;
            PG8_LDB(B0, 1, 0); PG8_LDB(B1, 1, 1); PG8_SCHED; PG8_LDA(At, 1, 0); PG8_STAGE(PG8_SA(0, 1), a2 + hstep, voffA);
            PG8_WAIT_V(8); PG8_WAIT_L(0); PG8_BAR; PG8_MMA(0, 0, At, B0); PG8_MMA(0, 1, At, B1); PG8_BAR; PG8_SCHED;
            PG8_LDA(At, 1, 1); PG8_STAGE(PG8_SB(1, 0), b3, voffB); PG8_STAGE(PG8_SB(1, 1), b3 + hstep, voffB); PG8_STAGE(PG8_SA(1, 0), a3, voffA);
            PG8_WAIT_V(8); PG8_WAIT_L(0); PG8_BAR; PG8_MMA(1, 0, At, B0); PG8_MMA(1, 1, At, B1); PG8_BAR; PG8_SCHED;
            } else {
            PG8_LDB(B0, 0, 0); PG8_SCHED; PG8_LDA(At, 0, 0); PG8_STAGE(PG8_SA(1, 1), a1 + hstep, voffA);
            PG8_WAIT_L(8); PG8_BAR; PG8_WAIT_L(0); PG8_MMA(0, 0, At, B0); PG8_BAR; PG8_SCHED;
            PG8_LDB(B1, 0, 1); PG8_STAGE(PG8_SB(0, 0), b2, voffB);
            PG8_BAR; PG8_WAIT_L(0); PG8_MMA(0, 1, At, B1); PG8_BAR;
            PG8_LDA(At, 0, 1); PG8_STAGE(PG8_SA(0, 0), a2, voffA);
            PG8_BAR; PG8_WAIT_L(0); PG8_MMA(1, 0, At, B0); PG8_BAR; PG8_SCHED;
            PG8_STAGE(PG8_SB(0, 1), b2 + hstep, voffB);
            PG8_WAIT_V(6); PG8_BAR; PG8_MMA(1, 1, At, B1); PG8_BAR;
            PG8_LDB(B0, 1, 0); PG8_SCHED; PG8_LDA(At, 1, 0); PG8_STAGE(PG8_SA(0, 1), a2 + hstep, voffA);
            PG8_WAIT_L(8); PG8_BAR; PG8_WAIT_L(0); PG8_MMA(0, 0, At, B0); PG8_BAR; PG8_SCHED;
            PG8_LDB(B1, 1, 1); PG8_STAGE(PG8_SB(1, 0), b3, voffB);
            PG8_BAR; PG8_WAIT_L(0); PG8_MMA(0, 1, At, B1); PG8_BAR;
            PG8_LDA(At, 1, 1); PG8_STAGE(PG8_SA(1, 0), a3, voffA);
            PG8_BAR; PG8_WAIT_L(0); PG8_MMA(1, 0, At, B0); PG8_BAR; PG8_SCHED;
            PG8_STAGE(PG8_SB(1, 1), b3 + hstep, voffB);
            PG8_WAIT_V(6); PG8_BAR; PG8_MMA(1, 1, At, B1); PG8_BAR;
            }
        }
        if constexpr (ALIGN_EPI) { if (wr == 0) PG8_BAR; }
        if constexpr (!Epi::AFTER_DRAIN) { E(acc, cur, wr, wc, fr, fq); S.done(cur); }
        if (!has_next) break;
#pragma unroll
        for (int a = 0; a < 2; ++a)
#pragma unroll
            for (int b = 0; b < 2; ++b)
#pragma unroll
                for (int m = 0; m < 4; ++m)
#pragma unroll
                    for (int n = 0; n < 2; ++n) acc[a][b][m][n] = (f32x4){0.f, 0.f, 0.f, 0.f};
        cur = nxt; cA = nA; cB = nB; ++ui;
        if constexpr (ALIGN_EPI) { if (wr == 1) PG8_BAR; }
    }
    PG8_WAIT_V(0);
    if constexpr (!ALIGN_EPI) { if (wr == 0) PG8_BAR; }
    PG8_BAR;
    if constexpr (Epi::AFTER_DRAIN) { E.fused(acc, cur, wr, wc, fr, fq, lds, wid, lane); S.done(cur); }
#undef PG8_SA
#undef PG8_SB
#undef PG8_STAGE
#undef PG8_LDA
#undef PG8_LDB
#undef PG8_MMA
#undef PG8_WAIT_V
#undef PG8_WAIT_L
#undef PG8_BAR
#undef PG8_SCHED
}
}

namespace pg8 {
struct EpiMulti {
    static constexpr bool PERM = true, AFTER_DRAIN = false;
    int mode, li;
    static __device__ __forceinline__ v4u pack8(f32x4 a, f32x4 b) { v4u w; w.x = cvt_pk_bf16(a[0], a[1]); w.y = cvt_pk_bf16(a[2], a[3]); w.z = cvt_pk_bf16(b[0], b[1]); w.w = cvt_pk_bf16(b[2], b[3]); return w; }
    __device__ __forceinline__ void operator()(const f32x4 (&acc)[2][2][4][2], const Unit& u, int wr, int wc, int fr, int fq) const {
        const int rt = u.pm * BM + wr * 64 + fr, ct = wc * 32 + 8 * fq;
        unsigned char* ws = KWS();
        if (mode == 1 && u.pm < MPAD / BM) {
            const int pn = u.pn;
            if (pn >= 16 && pn < 20) {
                float* U = (float*)(ws + W_U); float* out = KOUT(); const int cb = (pn - 16) * 128 + ct;
#pragma unroll
                for (int ai = 0; ai < 2; ++ai)
#pragma unroll
                    for (int m = 0; m < 4; ++m) { const int row = rt + ai * HALF + m * 16; f32x4 r0, r1;
#pragma unroll
                        for (int e = 0; e < 4; ++e) { r0[e] = acc[ai][0][m][0][e] * sigmoidf(acc[ai][1][m][0][e]); r1[e] = acc[ai][0][m][1][e] * sigmoidf(acc[ai][1][m][1][e]); }
                        float* d = U + (size_t)row * CCH + cb; *(f32x4*)d = r0; *(f32x4*)(d + 4) = r1;
                        if (row < MP) { const int s = row & (SEQ - 1); if (s >= SEQ - 30) { float* o = out + O_CVP + ((size_t)(li * BATCH + (row >> 12)) * 30 + (s - (SEQ - 30))) * CCH + cb; *(f32x4*)o = r0; *(f32x4*)(o + 4) = r1; } }
                        else if (row < MT) { const int b = (row - MP) >> 3, t = (row - MP) & 7; float* o = out + O_CVS + ((size_t)(li * DB + b) * 30 + 22 + t) * CCH + cb; *(f32x4*)o = r0; *(f32x4*)(o + 4) = r1; } }
            } else {
                size_t dsto; int ld, cofs, act; size_t fo_p = 0, fo_s = 0; bool f32o = false;
                if (pn < 4) { dsto = W_QB; ld = 1024; cofs = pn * 256; act = 1; }
                else if (pn < 8) { dsto = W_KD; ld = 0; cofs = (pn - 4) * 256; act = 0; f32o = true; fo_p = O_AKP; fo_s = O_AKS; }
                else if (pn < 12) { dsto = W_VD; ld = 0; cofs = (pn - 8) * 256; act = 0; f32o = true; fo_p = O_AVP; fo_s = O_AVS; }
                else if (pn < 16) { dsto = W_GAB; ld = 1024; cofs = (pn - 12) * 256; act = 2; }
                else if (pn < 22) { dsto = W_GCB; ld = 512; cofs = (pn - 20) * 256; act = 2; }
                else if (pn < 24) { dsto = W_QMB; ld = 512; cofs = (pn - 22) * 256; act = 1; }
                else { dsto = W_GMB; ld = 512; cofs = (pn - 24) * 256; act = 2; }
                bf16_t* D = (bf16_t*)(ws + dsto); float* out = KOUT();
#pragma unroll
                for (int ai = 0; ai < 2; ++ai)
#pragma unroll
                    for (int m = 0; m < 4; ++m) { const int row = rt + ai * HALF + m * 16;
#pragma unroll
                        for (int bj = 0; bj < 2; ++bj) { f32x4 v0 = acc[ai][bj][m][0], v1 = acc[ai][bj][m][1]; const int col = cofs + bj * HALF + ct;
                            if (f32o) {
                                if (row < MP) { const int s = row & (SEQ - 1); if (s >= SEQ - WIN) { float* o = out + fo_p + ((size_t)(li * BATCH + (row >> 12)) * WIN + (s - (SEQ - WIN))) * 1024 + col; *(f32x4*)o = v0; *(f32x4*)(o + 4) = v1; } }
                                else if (row < MT) { const int b = (row - MP) >> 3, t = (row - MP) & 7; float* o = out + fo_s + ((size_t)(li * DB + b) * WIN + (WIN - DS) + t) * 1024 + col; *(f32x4*)o = v0; *(f32x4*)(o + 4) = v1; } }
                            if (act == 1) { v0 = v0 * QS; v1 = v1 * QS; }
                            else if (act == 2) {
#pragma unroll
                                for (int e = 0; e < 4; ++e) { v0[e] = silu(v0[e]); v1[e] = silu(v1[e]); } }
                            if (ld) *(v4u*)(D + (size_t)row * ld + col) = pack8(v0, v1);
                            else if (row < MP) {
                                const v4u w = pack8(v0, v1); const int bh = (row >> 12) * NH + (col >> 7), pos = row & (SEQ - 1), dh = col & 127;
                                *(v4u*)(D + ((size_t)bh * SEQ + pos) * HD + dh) = w; } } }
            }
        } else if (mode == 2) {
            bf16_t* Y = (bf16_t*)(ws + W_Y); float* YSQ = (float*)(ws + W_YSQ);
#pragma unroll
            for (int ai = 0; ai < 2; ++ai)
#pragma unroll
                for (int m = 0; m < 4; ++m) { const int row = rt + ai * HALF + m * 16; float s = 0.f;
#pragma unroll
                    for (int bj = 0; bj < 2; ++bj) { const f32x4 v0 = acc[ai][bj][m][0], v1 = acc[ai][bj][m][1];
                        *(v4u*)(Y + (size_t)row * DM + u.pn * BM + bj * HALF + ct) = pack8(v0, v1);
                        s += (v0[0] * v0[0] + v0[1] * v0[1]) + (v0[2] * v0[2] + v0[3] * v0[3]) + (v1[0] * v1[0] + v1[1] * v1[1]) + (v1[2] * v1[2] + v1[3] * v1[3]); }
                    s += __shfl_xor(s, 16); s += __shfl_xor(s, 32);
                    if (fq == 0) YSQ[(size_t)row * 32 + u.pn * 4 + wc] = s; }
        } else if (mode == 3) {
            const bf16_t* G = (const bf16_t*)(ws + W_GCB); bf16_t* MIX = (bf16_t*)(ws + W_MIX);
#pragma unroll
            for (int ai = 0; ai < 2; ++ai)
#pragma unroll
                for (int m = 0; m < 4; ++m) { const int row = rt + ai * HALF + m * 16;
#pragma unroll
                    for (int bj = 0; bj < 2; ++bj) { const int col = u.pn * BM + bj * HALF + ct; const v4u g = *(const v4u*)(G + (size_t)row * CCH + col);
                        f32x4 v0 = acc[ai][bj][m][0], v1 = acc[ai][bj][m][1];
                        v0[0] *= bflo(g.x); v0[1] *= bfhi(g.x); v0[2] *= bflo(g.y); v0[3] *= bfhi(g.y); v1[0] *= bflo(g.z); v1[1] *= bfhi(g.z); v1[2] *= bflo(g.w); v1[3] *= bfhi(g.w);
                        *(v4u*)(MIX + (size_t)row * MIXW + 1024 + col) = pack8(v0, v1); } }
        } else {
            const int pnm = u.pn - INW / BM, layer = pnm >> 2, q = pnm & 3, isv = q >> 1; float* out = KOUT() + (isv ? O_MVP : O_MKP); bf16_t* D = (bf16_t*)(ws + (isv ? W_MVB : W_MKB));
#pragma unroll
            for (int ai = 0; ai < 2; ++ai)
#pragma unroll
                for (int m = 0; m < 4; ++m) { const int row = rt - MPAD + ai * HALF + m * 16;
#pragma unroll
                    for (int bj = 0; bj < 2; ++bj) { const size_t o = ((size_t)layer * 512 + row) * 512 + (q & 1) * 256 + bj * HALF + ct; const f32x4 v0 = acc[ai][bj][m][0], v1 = acc[ai][bj][m][1];
                        *(f32x4*)(out + o) = v0; *(f32x4*)(out + o + 4) = v1; *(v4u*)(D + o) = pack8(v0, v1); } }
        }
    }
};
}
__device__ __forceinline__ void transpose_item(const float* __restrict__ W, const float* __restrict__ g, int K, int N, bf16_t* __restrict__ WT, float* scr, int item, int lane, bool glu) {
    const int nblk = N / 32, kb = item / nblk, nb = item % nblk, k0 = 64 * kb, n0 = 32 * nb;
    int d0 = n0;
    if (glu && n0 >= 4096 && n0 < 5120) { const int isg = n0 >= 4608, r = n0 - (isg ? 4608 : 4096); d0 = 4096 + (r >> 7) * 256 + isg * 128 + (r & 127); }
    float wv[32];
#pragma unroll
    for (int i = 0; i < 32; ++i) wv[i] = __builtin_nontemporal_load(W + (size_t)(k0 + 2 * i + (lane >> 5)) * N + n0 + (lane & 31));
#pragma unroll
    for (int i = 0; i < 32; ++i) { const int kk = 2 * i + (lane >> 5); float v = wv[i]; if (g) v *= g[k0 + kk]; scr[kk * 33 + (lane & 31)] = v; }
    asm volatile("s_waitcnt lgkmcnt(0)" ::: "memory");
    const int c = lane & 7;
#pragma unroll
    for (int j = 0; j < 4; ++j) { const int n = (lane >> 3) + 8 * j; const float* s = scr + (8 * c) * 33 + n;
        v4u o; o.x = pk2(s[0 * 33], s[1 * 33]); o.y = pk2(s[2 * 33], s[3 * 33]); o.z = pk2(s[4 * 33], s[5 * 33]); o.w = pk2(s[6 * 33], s[7 * 33]);
        *(v4u*)(WT + (size_t)(d0 + n) * K + k0 + 8 * c) = o; }
    asm volatile("s_waitcnt lgkmcnt(0)" ::: "memory");
}

constexpr int I_IN = (DM / 64) * (INW / 32), I_OUT = (MIXW / 64) * (DM / 32), I_PW = (CCH / 64) * (CCH / 32), I_MKV = (DM / 64) * (1024 / 32);
constexpr int W_ITEMS = I_IN + I_OUT + I_PW;
constexpr size_t CH4 = (size_t)(WIN - DS) * 1024 / 4;
constexpr int C_ITEMS = (int)((size_t)DEPTH * DB * CH4 / 1024);
static_assert((size_t)C_ITEMS * 1024 == (size_t)DEPTH * DB * CH4, "cache shift items");
__device__ __forceinline__ void w_item(int L, int r, float* scr, int lane) {
  if (r < I_IN) { transpose_item(KIN(I_WIN) + (size_t)L * DM * INW, KIN(I_GPRE) + L * DM, DM, INW, WIN_L(L), scr, r, lane, true); return; } r -= I_IN;
  if (r < I_OUT) { transpose_item(KIN(I_WOUT) + (size_t)L * MIXW * DM, nullptr, MIXW, DM, WSP(bf16_t, W_WOUT) + (size_t)L * DM * MIXW, scr, r, lane, false); return; } r -= I_OUT;
  transpose_item(KIN(I_WPW) + (size_t)L * CCH * CCH, nullptr, CCH, CCH, WSP(bf16_t, W_WPW) + (size_t)L * CCH * CCH, scr, r, lane, false);
}
__device__ __forceinline__ void c_item(int q, int lane) {
  const f4* ck = (const f4*)KIN(I_CK); const f4* cv = (const f4*)KIN(I_CV); f4* ok = (f4*)(KOUT() + O_AKS); f4* ov = (f4*)(KOUT() + O_AVS);
  const size_t i0 = (size_t)q * 1024; const size_t lb = i0 / CH4, r0 = i0 % CH4;
  const size_t so = lb * ((size_t)WIN * 256) + DS * 256 + r0 + lane, dof = lb * ((size_t)WIN * 256) + r0 + lane;
  f4 a[8], b[8];
#pragma unroll
  for (int h = 0; h < 2; ++h) {
#pragma unroll
    for (int j = 0; j < 8; ++j) { a[j] = __builtin_nontemporal_load(ck + so + (h * 8 + j) * 64); b[j] = __builtin_nontemporal_load(cv + so + (h * 8 + j) * 64); }
#pragma unroll
    for (int j = 0; j < 8; ++j) { __builtin_nontemporal_store(a[j], ok + dof + (h * 8 + j) * 64); __builtin_nontemporal_store(b[j], ov + dof + (h * 8 + j) * 64); } }
}
static_assert(CH4 % 1024 == 0, "cache shift item size");
constexpr int NSLOT_W = 3312;
__device__ __forceinline__ void ph_filler(int li, int vs0, int nv, int nvs, float* lds_f, int wave_s) {
  OPAQUE_IDS
  const int lane = tid_ & 63; float* scr = lds_f + wave_s * (64 * 33);
  constexpr int CQ = C_ITEMS / DEPTH;
  for (int v = vs0; v < vs0 + nv; ++v) {
    if (li + 1 < DEPTH) for (int r = v; r < W_ITEMS; r += nvs) w_item(li + 1, r, scr, lane);
#ifndef COPY_IN_PROLOGUE
    for (int q = v; q < CQ; q += nvs) c_item(li * CQ + q, lane);
#endif
  }
}
static_assert(C_ITEMS % DEPTH == 0, "cache shift quarter");

__device__ __forceinline__ void ph_prologue(float* lds_f, int wave_s) {
  OPAQUE_IDS
  const int lane = tid_ & 63, wave = tid_ >> 6;
  float* scr = lds_f + wave * (64 * 33);
  for (int it = GW; it < W_ITEMS + DEPTH * I_MKV; it += NGW) {
    if (it < W_ITEMS) w_item(0, it, scr, lane);
    else { const int r = it - W_ITEMS, L = r / I_MKV; transpose_item(KIN(I_WMKV) + (size_t)L * DM * 1024, nullptr, DM, 1024, WSP(bf16_t, W_WMKV) + (size_t)L * 1024 * DM, scr, r % I_MKV, lane, false); }
  }
#ifdef COPY_IN_PROLOGUE
  for (int q = GW; q < C_ITEMS; q += NGW) c_item(q, lane);
#endif
  { const float* mem_prompt = KIN(I_MEM); bf16_t* memb = WSP(bf16_t, W_MEMB);
    for (size_t i = GT; i < (size_t)512 * DM; i += NGT) memb[i] = (bf16_t)f2bf(mem_prompt[i]); }
  {
    const f4* ck = (const f4*)KIN(I_CMK); const f4* cv = (const f4*)KIN(I_CMV); unsigned long long* ok = WSP(unsigned long long, W_CMKB); unsigned long long* ov = WSP(unsigned long long, W_CMVB);
    for (size_t i = GT; i < (size_t)DEPTH * DB * NMEM * 512 / 4; i += NGT) { const f4 a = ck[i], b = cv[i];
      ok[i] = (unsigned long long)pk2(a[0], a[1]) | ((unsigned long long)pk2(a[2], a[3]) << 32); ov[i] = (unsigned long long)pk2(b[0], b[1]) | ((unsigned long long)pk2(b[2], b[3]) << 32); } }
  {
    const float* xp = KIN(I_XP); const float* xs = KIN(I_XS); bf16_t* xa = WSP(bf16_t, W_XA);
    for (int w = MT + GW; w < MPAD; w += NGW) { unsigned long long* o = (unsigned long long*)(xa + (size_t)w * DM); for (int j = 0; j < 8; ++j) o[lane + 64 * j] = 0ull; }
#define PR_XR(w) ((const f4*)(((w) < MP) ? xp + (size_t)(w) * DM : xs + (size_t)((w) - MP) * DM))
    int w = GW;
    if (w < MT) {
      f4 v[8];
#pragma unroll
      for (int j = 0; j < 8; ++j) v[j] = PR_XR(w)[lane + 64 * j];
      for (;;) {
        const int wn = w + NGW; const bool more = wn < MT; f4 vn[8];
        if (more) {
#pragma unroll
          for (int j = 0; j < 8; ++j) vn[j] = PR_XR(wn)[lane + 64 * j]; }
        float s = 0.f;
#pragma unroll
        for (int j = 0; j < 8; ++j) s += (v[j][0] * v[j][0] + v[j][1] * v[j][1]) + (v[j][2] * v[j][2] + v[j][3] * v[j][3]);
        const float rstd = rsqrtf(wave_sum(s) / DM + EPS); unsigned long long* o = (unsigned long long*)(xa + (size_t)w * DM);
#pragma unroll
        for (int j = 0; j < 8; ++j) o[lane + 64 * j] = (unsigned long long)pk2(v[j][0] * rstd, v[j][1] * rstd) | ((unsigned long long)pk2(v[j][2] * rstd, v[j][3] * rstd) << 32);
        if (!more) break;
        w = wn;
#pragma unroll
        for (int j = 0; j < 8; ++j) v[j] = vn[j];
      }
    }
#undef PR_XR
  }
  {
    const float* st = KIN(I_ST); float* o = KOUT() + O_CVS;
    for (size_t i = GT; i < (size_t)DEPTH * DB * 22 * CCH; i += NGT) { const size_t lb = i / (22 * CCH), r = i % (22 * CCH); o[lb * 30 * CCH + r] = st[lb * 30 * CCH + 8 * CCH + r]; } }
}

namespace att {
using bf16x8 = __attribute__((ext_vector_type(8))) short;
using s16x4  = __attribute__((ext_vector_type(4))) short;
using f32x16 = __attribute__((ext_vector_type(16))) float;
using u32x4  = __attribute__((ext_vector_type(4))) unsigned;
using f32x8  = __attribute__((ext_vector_type(8))) float;
constexpr int TBL_N = 192, TBL_O = 32, LDS_TBL = 131072, LDS_WSF = LDS_TBL + 3 * NH * TBL_N * 4;
static_assert(LDS_WSF + 8 * 128 * 4 <= LDS_MISC && LDS_MISC + 64 <= LDS_BYTES, "attention LDS map");
constexpr float THR = 4.f;
#define KSWZ(row, colB) ((row) * 256 + ((colB) ^ (((row) & 7) << 4)))
#define SBAR() __builtin_amdgcn_sched_barrier(0)
__device__ __forceinline__ int crow(int r, int hi) { return (r & 3) + 8 * (r >> 2) + 4 * hi; }
__device__ __forceinline__ unsigned cvtpk(float lo, float hi) { unsigned r; asm volatile("v_cvt_pk_bf16_f32 %0, %1, %2" : "=v"(r) : "v"(lo), "v"(hi)); return r; }
__device__ __forceinline__ int v_st(int k, int c) { const int kk = (k & ~0xC) | ((k & 4) << 1) | ((k & 8) >> 1); return ((kk >> 3) * 4 + (c >> 5)) * 512 + ((kk & 7) * 32 + (c & 31)) * 2; }
__device__ __forceinline__ int v_rd_base(int lane) { return ((lane & 3) << 3) | (((lane >> 2) & 3) << 6) | (((lane >> 4) & 1) << 5) | (((lane >> 5) & 1) << 8); }
constexpr int v_rd_off(int d0, int ks, int half) { return d0 * 512 + ks * 4096 + half * 2048; }
template <int OFF> __device__ __forceinline__ s16x4 tr_read(int vb) { s16x4 r; asm volatile("ds_read_b64_tr_b16 %0, %1 offset:%2" : "=&v"(r) : "v"(vb), "i"(OFF) : "memory"); return r; }
template <int D0> __device__ __forceinline__ void pv_one(f32x16& od, int vb, bf16x8 pa0, bf16x8 pa1) {
  const s16x4 l0 = tr_read<v_rd_off(D0, 0, 0)>(vb), h0 = tr_read<v_rd_off(D0, 0, 1)>(vb), l1 = tr_read<v_rd_off(D0, 1, 0)>(vb), h1 = tr_read<v_rd_off(D0, 1, 1)>(vb);
  asm volatile("s_waitcnt lgkmcnt(0)" ::: "memory"); SBAR();
#define PK(L, H) (bf16x8){L[0], L[1], L[2], L[3], H[0], H[1], H[2], H[3]}
  od = __builtin_amdgcn_mfma_f32_32x32x16_bf16(pa0, PK(l0, h0), od, 0, 0, 0);
  od = __builtin_amdgcn_mfma_f32_32x32x16_bf16(pa1, PK(l1, h1), od, 0, 0, 0);
#undef PK
}
__device__ __forceinline__ bf16x8 tobf(f32x8 x) { u32x4 w = {cvtpk(x[0], x[1]), cvtpk(x[2], x[3]), cvtpk(x[4], x[5]), cvtpk(x[6], x[7])}; return __builtin_bit_cast(bf16x8, w); }

struct Task {
  int row0, rstep, head;
  const bf16_t *Kb, *Vb;
  const float *Kc, *Vc, *Kn, *Vn;
  int q0, t0, pat, pend, nrows, rs;
};
template <bool SAMPLE, bool CROSS, int OUT>
__device__ __forceinline__ void wave_task(char* lds, int wave, int lane_in, const Task& T) {
  int lane = lane_in; asm volatile("" : "+v"(lane));
  const int r32 = lane & 31, hi = lane >> 5, rsub = lane >> 4, ch = lane & 15;
  char* Kl = lds + wave * 16384; char* Vl = Kl + 8192;
  float* wsf = (float*)(lds + LDS_WSF) + wave * 128;
  const int vb = (int)(unsigned)(uintptr_t)Vl + v_rd_base(lane);
  bf16x8 qr[8];
  { const bf16_t* Q0 = CROSS ? WSP(bf16_t, W_QMB) + (size_t)T.row0 * 512 + T.head * HD : WSP(bf16_t, W_QB) + (size_t)T.row0 * 1024 + T.head * HD; const int qstride = T.rstep * (CROSS ? 512 : 1024);
#pragma unroll
    for (int d0 = 0; d0 < 8; ++d0) qr[d0] = *(const bf16x8*)(Q0 + r32 * qstride + d0 * 16 + hi * 8); }
  float m_reg = -1e30f, l_reg = 0.f; f32x16 o[4] = {};
  const int RS = CROSS ? 1024 : T.rs;
  bf16x8 kst[8], vst[8];
  const int loff = rsub * RS + ch * 16;
#define LOAD_T(t) do { const char* kp_ = (const char*)T.Kb + (size_t)(t) * (32 * RS) + loff; const char* vp_ = (const char*)T.Vb + (size_t)(t) * (32 * RS) + loff; \
    _Pragma("unroll") for (int c = 0; c < 8; ++c) { kst[c] = *(const bf16x8*)(kp_ + c * 4 * RS); vst[c] = *(const bf16x8*)(vp_ + c * 4 * RS); } } while (0)
#define WRITE_T() do { _Pragma("unroll") for (int c = 0; c < 8; ++c) { *(bf16x8*)(Kl + KSWZ(4 * c + rsub, ch * 16)) = kst[c]; *(bf16x8*)(Vl + v_st(4 * c + rsub, ch * 8)) = vst[c]; } } while (0)
#define DIRECT_TILE(d, t) do { _Pragma("unroll") for (int c = 0; c < 8; ++c) { const int row = 4 * c + rsub; int pos = T.q0 + (32 * (t) + row - 128) * (d); pos = pos < 0 ? 0 : (pos > WIN + DS - 1 ? WIN + DS - 1 : pos); \
      const float* kr = (CROSS || pos < WIN) ? T.Kc + (size_t)pos * (CROSS ? 512 : 1024) : T.Kn + (size_t)(pos - DS) * 1024; const float* vr = (CROSS || pos < WIN) ? T.Vc + (size_t)pos * (CROSS ? 512 : 1024) : T.Vn + (size_t)(pos - DS) * 1024; \
      const f32x8 kf = *(const f32x8*)(kr + ch * 8), vf = *(const f32x8*)(vr + ch * 8); *(bf16x8*)(Kl + KSWZ(row, ch * 16)) = tobf(kf); *(bf16x8*)(Vl + v_st(row, ch * 8)) = tobf(vf); if ((c & 3) == 3) SBAR(); } } while (0)
  constexpr int NTL = CROSS ? NMEM / 32 : 5;
  int pi = T.pat, t = SAMPLE ? 0 : T.t0;
  if constexpr (!SAMPLE) LOAD_T(t);
  for (;;) {
    if constexpr (!SAMPLE) WRITE_T();
    else { if constexpr (CROSS) { const int q0s = 128; (void)q0s; }
           const int d = CROSS ? 1 : (pi == 0 ? 1 : pi == 1 ? 4 : 16); DIRECT_TILE(d, t); }
    int pin = pi, tn = t + 1;
    if (tn >= NTL) { tn = 0; pin = pi + 1; }
    const bool more = (SAMPLE && !CROSS) ? (pin < T.pend) : (tn != 0);
    if constexpr (!SAMPLE) { if (more) LOAD_T(tn); }
    f32x16 p0 = {};
#pragma unroll
    for (int d0 = 0; d0 < 8; ++d0) { const bf16x8 a = *(const bf16x8*)(Kl + KSWZ(r32, (d0 * 16 + hi * 8) * 2)); p0 = __builtin_amdgcn_mfma_f32_32x32x16_bf16(a, qr[d0], p0, 0, 0, 0); }
    if constexpr (!CROSS) { const float* tp = (const float*)(lds + LDS_TBL) + (pi * NH + T.head) * TBL_N + TBL_O + 32 * t + 4 * hi - (SAMPLE ? 0 : r32);
#pragma unroll
      for (int r = 0; r < 16; ++r) p0[r] += tp[(r & 3) + 8 * (r >> 2)]; }
    float pmax = p0[0];
#pragma unroll
    for (int r = 1; r < 16; ++r) pmax = fmaxf(pmax, p0[r]);
    { auto rr = __builtin_amdgcn_permlane32_swap(__float_as_uint(pmax), __float_as_uint(pmax), false, false); pmax = fmaxf(__uint_as_float(rr[0]), __uint_as_float(rr[1])); }
    float alpha = 1.f;
    if (!__all(pmax - m_reg <= THR)) { const float mn = fmaxf(m_reg, pmax); alpha = __builtin_amdgcn_exp2f(m_reg - mn); m_reg = mn;
      if (hi == 0) wsf[r32] = alpha; asm volatile("s_waitcnt lgkmcnt(0)" ::: "memory");
#pragma unroll
      for (int d = 0; d < 4; ++d)
#pragma unroll
        for (int r = 0; r < 16; ++r) o[d][r] *= wsf[crow(r, hi)]; }
    float ps = 0.f;
#pragma unroll
    for (int r = 0; r < 16; ++r) { p0[r] = __builtin_amdgcn_exp2f(p0[r] - m_reg); ps += p0[r]; }
    { auto rr = __builtin_amdgcn_permlane32_swap(__float_as_uint(ps), __float_as_uint(ps), false, false); ps = __uint_as_float(rr[0]) + __uint_as_float(rr[1]); }
    l_reg = l_reg * alpha + ps;
    bf16x8 pa0, pa1;
#define PK4(PP, BASE, OUT_) do { unsigned a0 = cvtpk(PP[BASE + 0], PP[BASE + 1]), a1 = cvtpk(PP[BASE + 2], PP[BASE + 3]), b0 = cvtpk(PP[BASE + 4], PP[BASE + 5]), b1 = cvtpk(PP[BASE + 6], PP[BASE + 7]); \
    auto r0 = __builtin_amdgcn_permlane32_swap(a0, b0, false, false); auto r1 = __builtin_amdgcn_permlane32_swap(a1, b1, false, false); \
    u32x4 w = {r0[0], r1[0], r0[1], r1[1]}; OUT_ = __builtin_bit_cast(bf16x8, w); } while (0)
    PK4(p0, 0, pa0); PK4(p0, 8, pa1);
#undef PK4
    SBAR();
    pv_one<0>(o[0], vb, pa0, pa1); pv_one<1>(o[1], vb, pa0, pa1); pv_one<2>(o[2], vb, pa0, pa1); pv_one<3>(o[3], vb, pa0, pa1);
    if (!more) break;
    pi = pin; t = tn;
  }
#undef LOAD_T
#undef WRITE_T
#undef DIRECT_TILE
  int lane_e = lane; asm volatile("" : "+v"(lane_e)); const int r32e = lane_e & 31, hie = lane_e >> 5;
  float fa = __builtin_amdgcn_rcpf(l_reg), fb = 0.f, fc = 0.f;
  const int nrows = T.nrows, rstep = T.rstep;
  if constexpr (OUT == 1) { if (hie == 0 && r32e < nrows) { float* Pm = (float*)((char*)WSP(float, W_PM) + T.pat * PM_BYTES) + (size_t)T.row0 * NH + T.head; float* Pl = (float*)((char*)WSP(float, W_PL) + T.pat * PM_BYTES) + (size_t)T.row0 * NH + T.head;
      Pm[r32e * rstep * NH] = m_reg; Pl[r32e * rstep * NH] = l_reg; } }
  if constexpr (OUT == 2) { const float* Pm = WSP(float, W_PM) + (size_t)T.row0 * NH + T.head; const float* Pl = WSP(float, W_PL) + (size_t)T.row0 * NH + T.head; const int po = r32e * rstep * NH;
    const float m1 = Pm[po], l1 = Pl[po], m2 = Pm[PM_BYTES / 4 + po], l2 = Pl[PM_BYTES / 4 + po]; const float M = fmaxf(m_reg, fmaxf(m1, m2));
    const float a = __builtin_amdgcn_exp2f(m_reg - M), a1 = __builtin_amdgcn_exp2f(m1 - M) * l1, a2 = __builtin_amdgcn_exp2f(m2 - M) * l2; const float inv = __builtin_amdgcn_rcpf(l_reg * a + a1 + a2); fa = a * inv; fb = a1 * inv; fc = a2 * inv; }
  if (hie == 0) { wsf[r32e] = fa; wsf[32 + r32e] = fb; wsf[64 + r32e] = fc; } asm volatile("s_waitcnt lgkmcnt(0)" ::: "memory");
  const int rse = lane_e >> 4, che = lane_e & 15;
  bf16_t* Po = (bf16_t*)((char*)WSP(bf16_t, W_PO) + (OUT == 1 ? T.pat : 0) * PO_BYTES) + (size_t)T.row0 * 1024 + T.head * HD + che * 8; const int pstride = rstep * 1024;
  bf16_t* Mx = WSP(bf16_t, W_MIX) + (size_t)T.row0 * MIXW + (CROSS ? 1536 : 0) + T.head * HD + che * 8; const int mstride = rstep * MIXW;
  const bf16_t* Gx = (CROSS ? WSP(bf16_t, W_GMB) + (size_t)T.row0 * 512 + T.head * HD : WSP(bf16_t, W_GAB) + (size_t)T.row0 * 1024 + T.head * HD) + che * 8; const int gstride = rstep * (CROSS ? 512 : 1024);
  v4u gq[8], p1q[8], p2q[8];
  if constexpr (OUT != 1) {
#pragma unroll
    for (int c = 0; c < 8; ++c) { const int row = 4 * c + rse; if (row < nrows) { gq[c] = *(const v4u*)(Gx + row * gstride);
        if constexpr (OUT == 2) { p1q[c] = *(const v4u*)(Po + row * pstride); p2q[c] = *(const v4u*)(Po + PO_BYTES / 2 + row * pstride); } } } }
  float* so = (float*)Kl;
#pragma unroll
  for (int r = 0; r < 16; ++r) { const int orow = crow(r, hie); const float ra = wsf[orow];
#pragma unroll
    for (int d0 = 0; d0 < 4; ++d0) so[orow * 128 + d0 * 32 + r32e] = o[d0][r] * ra; }
  asm volatile("s_waitcnt lgkmcnt(0)" ::: "memory");
#pragma unroll
  for (int c = 0; c < 8; ++c) { const int row = 4 * c + rse;
    if (row < nrows) {
      f4 x0 = *(const f4*)(so + row * 128 + che * 8), x1 = *(const f4*)(so + row * 128 + che * 8 + 4);
      if constexpr (OUT == 1) { v4u w; w.x = pk2(x0[0], x0[1]); w.y = pk2(x0[2], x0[3]); w.z = pk2(x1[0], x1[1]); w.w = pk2(x1[2], x1[3]); *(v4u*)(Po + row * pstride) = w; }
      else {
        if constexpr (OUT == 2) { const float rb = wsf[32 + row], rc = wsf[64 + row]; const v4u p1 = p1q[c], p2 = p2q[c];
          x0[0] += bflo(p1.x) * rb + bflo(p2.x) * rc; x0[1] += bfhi(p1.x) * rb + bfhi(p2.x) * rc; x0[2] += bflo(p1.y) * rb + bflo(p2.y) * rc; x0[3] += bfhi(p1.y) * rb + bfhi(p2.y) * rc;
          x1[0] += bflo(p1.z) * rb + bflo(p2.z) * rc; x1[1] += bfhi(p1.z) * rb + bfhi(p2.z) * rc; x1[2] += bflo(p1.w) * rb + bflo(p2.w) * rc; x1[3] += bfhi(p1.w) * rb + bfhi(p2.w) * rc; }
        const v4u g = gq[c];
        v4u w; w.x = pk2(x0[0] * bflo(g.x), x0[1] * bfhi(g.x)); w.y = pk2(x0[2] * bflo(g.y), x0[3] * bfhi(g.y)); w.z = pk2(x1[0] * bflo(g.z), x1[1] * bfhi(g.z)); w.w = pk2(x1[2] * bflo(g.w), x1[3] * bfhi(g.w));
        *(v4u*)(Mx + row * mstride) = w; } } }
  asm volatile("s_waitcnt lgkmcnt(0)" ::: "memory");
}
#undef KSWZ
#undef SBAR
}

__device__ __forceinline__ void build_bias_tables(char* lds, int wave_s) {
  OPAQUE_IDS
  const float* rel_bias = KIN(I_RB); float* tbl = (float*)(lds + att::LDS_TBL);
  for (int i = tid_; i < 3 * NH * att::TBL_N; i += NT) { const int p = i / (NH * att::TBL_N), h = (i / att::TBL_N) % NH, x = i % att::TBL_N - att::TBL_O;
    tbl[i] = (x >= 0 && x <= 128) ? rel_bias[BUCKET[p][128 - x] * NH + h] * LOG2E : -INFINITY; }
}
__device__ __forceinline__ att::Task prompt_task(int pat, int b, int h, int r, int i0) {
  const int d = (pat == 0) ? 1 : (pat == 1) ? 4 : 16;
  att::Task T{}; T.row0 = b * SEQ + r + d * i0; T.rstep = d; T.head = h; T.pat = pat; T.nrows = 32; T.t0 = i0 >= 128 ? 0 : (128 - i0) >> 5;
  const size_t e0 = ((size_t)(b * NH + h) * SEQ + r + (size_t)d * i0) * HD;
  T.rs = 256 * d;
  T.Kb = WSP(bf16_t, W_KD) + e0 - (size_t)128 * d * HD; T.Vb = WSP(bf16_t, W_VD) + e0 - (size_t)128 * d * HD;
  return T;
}
__device__ __forceinline__ att::Task sample_task(int li, int b, int h, int t, int pbeg, int pend) {
  att::Task T{}; const size_t cb = ((size_t)(li * DB + b) * WIN) * 1024 + h * HD;
  T.row0 = MP + b * DS + t; T.rstep = 0; T.head = h; T.Kc = KIN(I_CK) + cb; T.Vc = KIN(I_CV) + cb; T.Kn = KOUT() + O_AKS + cb; T.Vn = KOUT() + O_AVS + cb;
  T.q0 = WIN + t; T.nrows = 1; T.pat = pbeg; T.pend = pend;
  return T;
}
__device__ __forceinline__ void cross_tasks(int li, char* lds, int wave, int lane, int t_lo, int t_hi, int slot, int nslots) {
  constexpr int NTASK_P = (MP / 32) * NXH;
  for (int tk = t_lo + slot; tk < t_hi; tk += nslots) {
    att::Task T{}; T.rstep = 1; T.t0 = 0; T.pat = 0; T.q0 = 128;
    if (tk < NTASK_P) {
      const int h = tk & 3, rt = tk >> 2, b = rt >> 7; const size_t kvo = ((size_t)li * 512 + b * NMEM) * 512 + h * HD;
      T.row0 = rt * 32; T.head = h; T.Kb = WSP(bf16_t, W_MKB) + kvo; T.Vb = WSP(bf16_t, W_MVB) + kvo; T.nrows = 32;
      att::wave_task<false, true, 0>(lds, wave, lane, T);
    } else {
      const int h = (tk - NTASK_P) & 3, b = (tk - NTASK_P) >> 2; const size_t kvo = ((size_t)(li * DB + b) * NMEM) * 512 + h * HD;
      T.row0 = MP + b * DS; T.head = h; T.Kb = WSP(bf16_t, W_CMKB) + kvo; T.Vb = WSP(bf16_t, W_CMVB) + kvo; T.nrows = DS;
      att::wave_task<false, true, 0>(lds, wave, lane, T);
    }
  }
}
__device__ __forceinline__ void ph_attn1(int li, char* lds, int wave_s) {
  OPAQUE_IDS
  const int lane = tid_ & 63, wave = wave_s;
  { const int x = bid_ & 7, j = (bid_ >> 3) * 8 + wave;
    for (int jj = j; jj < 256; jj += (nb_ >> 3) * 8) { const int bh = 2 * x + (jj >> 7), qt = jj & 127;
      { att::Task T = prompt_task(0, bh >> 3, bh & 7, 0, qt * 32); att::wave_task<false, false, 1>(lds, wave, lane, T); }
      { att::Task T = prompt_task(1, bh >> 3, bh & 7, qt >> 5, (qt & 31) * 32); att::wave_task<false, false, 1>(lds, wave, lane, T); } } }
  if (wave < 4) { for (int tk = bid_ * 4 + wave; tk < 2 * DB * NH * DS; tk += nb_ * 4) { const int pat = tk & 1, q = tk >> 1;
      att::Task T = sample_task(li, q >> 6, (q >> 3) & 7, q & 7, pat, pat + 1); att::wave_task<true, false, 1>(lds, wave, lane, T); } }
  else cross_tasks(li, lds, wave, lane, 0, (MP / 32) * NXH, bid_ * 4 + (wave - 4), nb_ * 4);
}
__device__ __forceinline__ void ph_attn2(int li, char* lds, int wave_s) {
  OPAQUE_IDS
  const int lane = tid_ & 63, wave = wave_s;
  const int x = bid_ & 7, j = (bid_ >> 3) * 8 + wave;
  for (int jj = j; jj < 256; jj += (nb_ >> 3) * 8) { const int bh = 2 * x + (jj >> 7), r16 = (jj >> 3) & 15, it = jj & 7;
    att::Task T = prompt_task(2, bh >> 3, bh & 7, r16, it * 32);
    att::wave_task<false, false, 2>(lds, wave, lane, T); }
  { const int vb_ = (bid_ + nb_ - 66 % nb_) % nb_;
    for (int q = vb_ * 8 + wave; q < DB * NH * DS; q += nb_ * 8) { att::Task T = sample_task(li, q >> 6, (q >> 3) & 7, q & 7, 2, 3); att::wave_task<true, false, 2>(lds, wave, lane, T); } }
  { const int vb2 = (bid_ + nb_ - 130 % nb_) % nb_;
    if (wave == 0) cross_tasks(li, lds, wave, lane, (MP / 32) * NXH, (MP / 32) * NXH + DB * NXH, vb2, nb_); }
}
__device__ __forceinline__ void ph_conv_tiles(int li, char* lds, int wave_s) {
  OPAQUE_IDS
  const int c = tid_, lane = tid_ & 63, wave = tid_ >> 6;
  const float* u = WSP(float, W_U); const float* state = KIN(I_ST) + (size_t)li * DB * 30 * CCH; const float* wdw = KIN(I_WDW) + (size_t)li * CK * CCH;
  const float* lg = KIN(I_LNG) + li * CCH; const float* lb = KIN(I_LNB) + li * CCH; bf16_t* cact = WSP(bf16_t, W_CACT);
  float* tile = (float*)lds;
  for (int tl = bid_; tl < MP / 32 + DB; tl += nb_) {
    const bool samp = tl >= MP / 32;
    const int ntok = samp ? DS : 32;
    float win[62];
    if (!samp) { const int t0 = (tl * 32) & (SEQ - 1); const float* ub = u + (size_t)(tl * 32 - 30) * CCH + c;
#pragma unroll
      for (int k = 0; k < 62; ++k) win[k] = (t0 - 30 + k >= 0) ? ub[(size_t)k * CCH] : 0.f; }
    else { const int b = tl - MP / 32; const float* sb = state + (size_t)b * 30 * CCH + c; const float* ub = u + (size_t)(MP + b * DS) * CCH + c;
#pragma unroll
      for (int k = 0; k < 62; ++k) win[k] = (k < 30) ? sb[(size_t)k * CCH] : (k < 30 + DS ? ub[(size_t)(k - 30) * CCH] : 0.f); }
    float w[CK];
#pragma unroll
    for (int k = 0; k < CK; ++k) w[k] = wdw[k * CCH + c];
    const float bias = KIN(I_BDW)[li * CCH + c];
    __syncthreads();
#pragma unroll
    for (int t = 0; t < 32; ++t) { if (t < ntok) { float a = bias;
#pragma unroll
      for (int k = 0; k < CK; ++k) a += w[k] * win[t + k];
      tile[t * CCH + c] = a; } }
    __syncthreads();
#pragma unroll
    for (int j = 0; j < 4; ++j) { const int t = wave * 4 + j;
      if (t < ntok) {
        const f4 v0 = *(const f4*)(tile + t * CCH + lane * 8), v1 = *(const f4*)(tile + t * CCH + lane * 8 + 4);
        const float mean = wave_sum((v0[0] + v0[1]) + (v0[2] + v0[3]) + (v1[0] + v1[1]) + (v1[2] + v1[3])) * (1.f / CCH);
        const f4 d0 = v0 - mean, d1 = v1 - mean;
        const float rstd = rsqrtf(wave_sum((d0[0] * d0[0] + d0[1] * d0[1]) + (d0[2] * d0[2] + d0[3] * d0[3]) + (d1[0] * d1[0] + d1[1] * d1[1]) + (d1[2] * d1[2] + d1[3] * d1[3])) * (1.f / CCH) + EPS);
        const f4 g0 = *(const f4*)(lg + lane * 8), g1 = *(const f4*)(lg + lane * 8 + 4), b0 = *(const f4*)(lb + lane * 8), b1 = *(const f4*)(lb + lane * 8 + 4);
        const f4 y0 = d0 * rstd * g0 + b0, y1 = d1 * rstd * g1 + b1;
        v4u o; o.x = pk2(silu(y0[0]), silu(y0[1])); o.y = pk2(silu(y0[2]), silu(y0[3])); o.z = pk2(silu(y1[0]), silu(y1[1])); o.w = pk2(silu(y1[2]), silu(y1[3]));
        const size_t row = samp ? (size_t)MP + (tl - MP / 32) * DS + t : (size_t)tl * 32 + t;
        *(v4u*)(cact + row * CCH + lane * 8) = o; } }
  }
  __syncthreads();
}

__device__ __forceinline__ void ph_postpre(int li, int wave_s) {
  OPAQUE_IDS
  const int lane = tid_ & 63;
  const bf16_t* y = WSP(bf16_t, W_Y); const float* ysq = WSP(float, W_YSQ);
  float* xcur = WSP(float, W_XCUR); bf16_t* xa = WSP(bf16_t, W_XA); float* out = KOUT(); const float* xp = KIN(I_XP); const float* xs = KIN(I_XS);
  f4 gv[8];
  { const f4* g = (const f4*)(KIN(I_GPOST) + li * DM);
#pragma unroll
    for (int j = 0; j < 8; ++j) gv[j] = g[lane + 64 * j]; }
#define PP_XR(w) ((const f4*)((li == 0) ? (((w) < MP) ? xp + (size_t)(w) * DM : xs + (size_t)((w) - MP) * DM) : xcur + (size_t)(w) * DM))
#define PP_LOAD(w, X, Y, Q) do { const f4* xr_ = PP_XR(w); const unsigned long long* yr_ = (const unsigned long long*)(y + (size_t)(w) * DM); Q = ysq[(size_t)(w) * 32 + (lane & 31)]; \
    _Pragma("unroll") for (int j = 0; j < 8; ++j) { X[j] = xr_[lane + 64 * j]; Y[j] = yr_[lane + 64 * j]; } } while (0)
  int w = GW; if (w >= MT) return;
  f4 xv[8]; unsigned long long yv[8]; float q;
  PP_LOAD(w, xv, yv, q);
  for (;;) {
    const int wn = w + NGW; const bool more = wn < MT;
    f4 xn[8]; unsigned long long yn[8]; float qn = 0.f;
    if (more) PP_LOAD(wn, xn, yn, qn);
    const float rstd_y = rsqrtf(wave_sum(q) * 0.5f / DM + EPS);
    f4* xo = (f4*)((li == DEPTH - 1) ? ((w < MP) ? out + O_YP + (size_t)w * DM : out + O_YS + (size_t)(w - MP) * DM) : xcur + (size_t)w * DM);
    f4 v[8]; float s = 0.f;
#pragma unroll
    for (int j = 0; j < 8; ++j) { const unsigned long long yw = yv[j]; const f4 yf = {bflo((unsigned)yw), bfhi((unsigned)yw), bflo((unsigned)(yw >> 32)), bfhi((unsigned)(yw >> 32))};
      v[j] = xv[j] + yf * rstd_y * gv[j]; xo[lane + 64 * j] = v[j];
      s += (v[j][0] * v[j][0] + v[j][1] * v[j][1]) + (v[j][2] * v[j][2] + v[j][3] * v[j][3]); }
    if (li < DEPTH - 1) {
      const float rstd = rsqrtf(wave_sum(s) / DM + EPS); unsigned long long* o = (unsigned long long*)(xa + (size_t)w * DM);
#pragma unroll
      for (int j = 0; j < 8; ++j) o[lane + 64 * j] = (unsigned long long)pk2(v[j][0] * rstd, v[j][1] * rstd) | ((unsigned long long)pk2(v[j][2] * rstd, v[j][3] * rstd) << 32);
    }
    if (!more) break;
    w = wn; q = qn;
#pragma unroll
    for (int j = 0; j < 8; ++j) { xv[j] = xn[j]; yv[j] = yn[j]; }
  }
#undef PP_LOAD
#undef PP_XR
}

#define XB_TMO      128
#define XB_XCNT(j)  (256  + 64 * (j))
#define XB_XSUB(j)  (1280 + 64 * (j))
#define XB_XGEN(j)  (2304 + 64 * (j))
#define XB_TOP      3328
#define XB_TOPGEN   3392
#define XCD_BAR_WORDS 3456
#define XB_SPIN_CAP (1u << 20)
__device__ __forceinline__ unsigned xb_ld(unsigned* p)              { return __hip_atomic_load(p, __ATOMIC_RELAXED, __HIP_MEMORY_SCOPE_AGENT); }
__device__ __forceinline__ unsigned xb_add(unsigned* p, unsigned v) { return __hip_atomic_fetch_add(p, v, __ATOMIC_RELAXED, __HIP_MEMORY_SCOPE_AGENT); }
__device__ __forceinline__ unsigned xb_xcc_id() { return (unsigned)__builtin_amdgcn_s_getreg((3 << 11) | 20) & 0xFu; }
#define XB_SPIN(cond, bar) do { unsigned _sp = 0; while (cond) { __builtin_amdgcn_s_sleep(1); \
    if ((++_sp & 255u) == 0u) { if (xb_ld(&(bar)[XB_TMO])) break; if (_sp > XB_SPIN_CAP) { atomicAdd(&(bar)[XB_TMO], 1u); break; } } } } while (0)
__device__ __forceinline__ void xcd_barrier_post(unsigned* bar, int wave_s) { if (wave_s == 0 && lane_id_v() == 0) (void)xb_add(&bar[XB_XCNT(xb_xcc_id())], 1u); }
__device__ __forceinline__ void xcd_barrier_complete(unsigned* bar, unsigned x, unsigned G, unsigned& nloc, unsigned& nx) {
    unsigned sum, cnt, mine, sp = 0u;
    for (;;) {
        sum = 0u; cnt = 0u; mine = 0u;
#pragma unroll
        for (unsigned j = 0; j < 16; ++j) { const unsigned c = xb_ld(&bar[XB_XCNT(j)]); sum += c; cnt += (c > 0u) ? 1u : 0u; mine = (j == x) ? c : mine; }
        if (sum == G) break;
        __builtin_amdgcn_s_sleep(1);
        if ((++sp & 255u) == 0u) { if (xb_ld(&bar[XB_TMO])) break; if (sp > XB_SPIN_CAP) { atomicAdd(&bar[XB_TMO], 1u); break; } }
    }
    nloc = mine > 0u ? mine : 1u; nx = cnt > 0u ? cnt : 1u;
}
__device__ __forceinline__ void xcd_barrier(unsigned* bar, volatile LAS unsigned* st, int wave_s) {
    asm volatile("s_waitcnt vmcnt(0)" ::: "memory");
    __syncthreads();
    if (wave_s == 0 && lane_id_v() == 0) {
        __builtin_amdgcn_s_waitcnt(0);
        const unsigned x = xb_xcc_id();
        unsigned nloc = st[0], nx = st[1];
        if (nloc == 0u) { xcd_barrier_complete(bar, x, gridDim.x, nloc, nx); st[0] = nloc; st[1] = nx; }
        const unsigned old = xb_add(&bar[XB_XSUB(x)], 1u);
        const unsigned gen = old / nloc;
        if (old + 1u == (gen + 1u) * nloc) {
            __builtin_amdgcn_fence(__ATOMIC_RELEASE, "agent");
            asm volatile("s_waitcnt vmcnt(0)" ::: "memory");
            const unsigned og = xb_add(&bar[XB_TOP], 1u);
            const unsigned tg = og / nx;
            if (og + 1u == (tg + 1u) * nx) xb_add(&bar[XB_TOPGEN], 1u);
            else XB_SPIN(xb_ld(&bar[XB_TOPGEN]) == tg, bar);
            __builtin_amdgcn_fence(__ATOMIC_ACQUIRE, "agent");
            xb_add(&bar[XB_XGEN(x)], 1u);
            asm volatile("s_waitcnt vmcnt(0)" ::: "memory");
        } else {
            XB_SPIN(xb_ld(&bar[XB_XGEN(x)]) == gen, bar);
            __builtin_amdgcn_fence(__ATOMIC_ACQUIRE, "agent");
            asm volatile("s_waitcnt vmcnt(0)" ::: "memory");
        }
    }
    __syncthreads();
}

__global__ void __launch_bounds__(NT, 2) fwd_mega(Params p) {
  extern __shared__ __attribute__((aligned(16))) unsigned char lds[];
  cg::grid_group grid = cg::this_grid();
  PG8_LAS unsigned char* lds3 = (PG8_LAS unsigned char*)lds;
  const int wave_s = __builtin_amdgcn_readfirstlane(threadIdx.x >> 6);
  volatile LAS unsigned* bst = (volatile LAS unsigned*)((LAS unsigned char*)lds + LDS_MISC);
  if (threadIdx.x < 2) bst[threadIdx.x] = 0u;
  build_bias_tables((char*)lds, wave_s);
  ph_prologue((float*)lds, wave_s);
  if (KWS() == nullptr) grid.sync();
  xcd_barrier_post(WSP(unsigned, W_BAR), wave_s);
  xcd_barrier(WSP(unsigned, W_BAR), bst, wave_s);
#ifndef PROBE_SUB
#define PROBE_SUB -99
#endif
#pragma unroll 1
  for (int ph = 0; ph < DEPTH * 5; ++ph) {
    const int li = ph / 5, sub = ph % 5 + 1;
#pragma unroll 1
    for (int rep = 0; rep < ((sub == PROBE_SUB && (sub != 5 || li == 0 || li == DEPTH - 1)) ? 2 : 1); ++rep) {
    if (sub == 1 || sub == 3 || sub == 4) {
      pg8::Gemm g; pg8::EpiMulti E; int extra = 0;
      if (sub == 1) { g = pg8::Gemm{WSP(bf16_t, W_XA), WIN_L(li), MPAD, INW, DM}; E = pg8::EpiMulti{1, li}; extra = (li == 0) ? 32 : 0; }
      else if (sub == 3) { g = pg8::Gemm{WSP(bf16_t, W_CACT), WSP(bf16_t, W_WPW) + (size_t)li * CCH * CCH, MPAD, CCH, CCH}; E = pg8::EpiMulti{3, li}; }
      else { g = pg8::Gemm{WSP(bf16_t, W_MIX), WSP(bf16_t, W_WOUT) + (size_t)li * DM * MIXW, MPAD, DM, MIXW}; E = pg8::EpiMulti{2, li}; }
      int bid_ = blockIdx.x; asm volatile("" : "+s"(bid_)); int nb_ = gridDim.x; asm volatile("" : "+s"(nb_));
      pg8::StaticOrder S; S.init(g.M, g.N, nb_, bid_, extra);
      pg8::gemm_phase<pg8::EpiMulti, pg8::StaticOrder, true, true>(lds3, g, S, E, wave_s);
      if (sub == 1 || sub == 4) {
        const int nwgA = (MPAD / 256) * (INW / 256) + ((li == 0) ? 32 : 0), nwgC = (MPAD / 256) * (DM / 256);
        const int firstA = nwgA - (nwgA - 1) / nb_ * nb_, firstC = nwgC - (nwgC - 1) / nb_ * nb_;
        const int nslot = ((nb_ - firstA) + (nb_ - firstC)) * 8;
        const int first = (sub == 1) ? firstA : firstC;
        if (bid_ >= first) ph_filler(li, ((sub == 1) ? 0 : (nb_ - firstA) * 8) + (bid_ - first) * 8 + wave_s, 1, nslot, (float*)lds, wave_s);
      }
    }
    if (sub == 2) { ph_conv_tiles(li, (char*)lds, wave_s); ph_attn1(li, (char*)lds, wave_s); }
    else if (sub == 3) ph_attn2(li, (char*)lds, wave_s);
    else if (sub == 5) ph_postpre(li, wave_s);
    if (ph < DEPTH * 5 - 1) xcd_barrier(WSP(unsigned, W_BAR), bst, wave_s);
    }
  }
}

extern "C" void kernel_launch(void* const* d_in, const int* in_sizes, int n_in, void* d_out, int out_size, void* d_ws, size_t ws_size, hipStream_t stream) {
  static int grid_blocks = 0;
  if (!grid_blocks) {
    int dev = 0, cus = 0, per_cu = 0;
    (void)hipGetDevice(&dev);
    (void)hipDeviceGetAttribute(&cus, hipDeviceAttributeMultiprocessorCount, dev);
    (void)hipFuncSetAttribute((const void*)fwd_mega, hipFuncAttributeMaxDynamicSharedMemorySize, LDS_BYTES);
    (void)hipOccupancyMaxActiveBlocksPerMultiprocessor(&per_cu, (const void*)fwd_mega, NT, LDS_BYTES);
    if (per_cu < 1) { fprintf(stderr, "occupancy query returned %d\n", per_cu); per_cu = 1; }
    grid_blocks = cus * per_cu;
    if (ws_size < W_END) fprintf(stderr, "workspace too small: %zu < %zu\n", ws_size, (size_t)W_END);
  }
  (void)hipMemsetAsync((unsigned char*)d_ws + W_BAR, 0, 16384, stream);
  Params p{};
  for (int i = 0; i < 19; ++i) p.in[i] = (const float*)d_in[i];
  p.out = (float*)d_out; p.ws = (unsigned char*)d_ws;
  void* args[] = {&p};
  hipError_t e = hipLaunchCooperativeKernel((const void*)fwd_mega, dim3(grid_blocks), dim3(NT), args, LDS_BYTES, stream);
  if (e != hipSuccess) fprintf(stderr, "cooperative launch failed: %s (grid %d)\n", hipGetErrorString(e), grid_blocks);
}
```

```cpp
#include <hip/hip_runtime.h>
#include <hip/hip_cooperative_groups.h>
#include <cstdio>
#include <cstdint>
namespace cg = cooperative_groups;

constexpr int DM = 2048, BATCH = 2, SEQ = 4096, DEPTH = 4, DB = 8, DS = 8;
constexpr int NMEM = 256, HD = 128, ATT_W = 1024, NH = 8, WIN = 2048;
constexpr int CCH = 512, CK = 31, XW = 512, NXH = 4, MIXW = 2048, INW = 6656;
constexpr int MP = BATCH * SEQ;
constexpr int MS = DB * DS;
constexpr int MT = MP + MS;
constexpr int MPAD = 8448;
constexpr float EPS = 1e-6f;
constexpr float SCALE = 0.08838834764831845f, LOG2E = 1.4426950408889634f, QS = SCALE * LOG2E;
constexpr int NT = 512;
constexpr int LDS_BYTES = 155648;

__device__ const unsigned char BUCKET[3][129] = {
 {0,1,2,3,4,5,6,7,8,9,10,11,12,13,14,15,16,16,16,16,16,16,17,17,17,17,17,17,17,17,18,18,18,18,18,18,18,18,18,18,19,19,19,19,19,19,19,19,19,19,19,19,19,19,20,20,20,20,20,20,20,20,20,20,20,20,20,20,20,20,20,20,20,21,21,21,21,21,21,21,21,21,21,21,21,21,21,21,21,21,21,21,21,21,21,21,21,21,21,22,22,22,22,22,22,22,22,22,22,22,22,22,22,22,22,22,22,22,22,22,22,22,22,22,22,22,22,22,22},
 {0,4,8,12,16,16,17,17,18,18,19,19,19,19,20,20,20,20,20,21,21,21,21,21,21,22,22,22,22,22,22,22,22,22,23,23,23,23,23,23,23,23,23,23,23,23,24,24,24,24,24,24,24,24,24,24,24,24,24,24,24,24,25,25,25,25,25,25,25,25,25,25,25,25,25,25,25,25,25,25,25,25,25,26,26,26,26,26,26,26,26,26,26,26,26,26,26,26,26,26,26,26,26,26,26,26,26,26,26,26,26,26,26,27,27,27,27,27,27,27,27,27,27,27,27,27,27,27,27},
 {0,16,18,19,20,21,21,22,22,23,23,23,24,24,24,24,25,25,25,25,25,26,26,26,26,26,26,26,26,27,27,27,27,27,27,27,27,27,27,28,28,28,28,28,28,28,28,28,28,28,28,28,29,29,29,29,29,29,29,29,29,29,29,29,29,29,29,29,29,29,30,30,30,30,30,30,30,30,30,30,30,30,30,30,30,30,30,30,30,30,30,30,30,30,30,31,31,31,31,31,31,31,31,31,31,31,31,31,31,31,31,31,31,31,31,31,31,31,31,31,31,31,31,31,31,31,31,31,31}};

typedef unsigned short bf16_t;
typedef unsigned v4u __attribute__((ext_vector_type(4)));
typedef float f4 __attribute__((ext_vector_type(4)));
__device__ __forceinline__ unsigned f2bf(float f) { unsigned u = __builtin_bit_cast(unsigned, f); return (u + 0x7fffu + ((u >> 16) & 1u)) >> 16; }
__device__ __forceinline__ unsigned pk2(float lo, float hi) { unsigned r; asm("v_cvt_pk_bf16_f32 %0, %1, %2" : "=v"(r) : "v"(lo), "v"(hi)); return r; }
__device__ __forceinline__ float bf2f(unsigned short b) { return __builtin_bit_cast(float, (unsigned)b << 16); }
__device__ __forceinline__ float bflo(unsigned w) { return __builtin_bit_cast(float, w << 16); }
__device__ __forceinline__ float bfhi(unsigned w) { return __builtin_bit_cast(float, w & 0xffff0000u); }
__device__ __forceinline__ float wave_sum(float v) {
#pragma unroll
  for (int o = 1; o < 64; o <<= 1) v += __shfl_xor(v, o);
  return v;
}
__device__ __forceinline__ float sigmoidf(float x) { return __builtin_amdgcn_rcpf(1.f + __builtin_amdgcn_exp2f(-LOG2E * x)); }
__device__ __forceinline__ float silu(float x) { return x * sigmoidf(x); }

struct Params { const float* in[19]; float* out; unsigned char* ws; };
__device__ __forceinline__ unsigned long long karg(int k) {
  const volatile unsigned long long __attribute__((address_space(4)))* ka = (const volatile unsigned long long __attribute__((address_space(4)))*)__builtin_amdgcn_kernarg_segment_ptr();
  return ka[k];
}
#define GAS __attribute__((address_space(1)))
#define KIN(k) ((const float*)(const GAS float*)karg(k))
#define KOUT() ((float*)(GAS float*)karg(19))
#define KWS() ((unsigned char*)(GAS unsigned char*)karg(20))
enum { I_XP = 0, I_XS, I_MEM, I_CK, I_CV, I_ST, I_CMK, I_CMV, I_RB, I_GPRE, I_WIN, I_WDW, I_BDW, I_LNG, I_LNB, I_WPW, I_WMKV, I_WOUT, I_GPOST };
constexpr size_t O_YP = 0, O_YS = O_YP + (size_t)MP * DM, O_AKP = O_YS + (size_t)MS * DM, O_AVP = O_AKP + (size_t)DEPTH * BATCH * WIN * 1024,
  O_CVP = O_AVP + (size_t)DEPTH * BATCH * WIN * 1024, O_MKP = O_CVP + (size_t)DEPTH * BATCH * 30 * CCH, O_MVP = O_MKP + (size_t)DEPTH * 512 * 512,
  O_AKS = O_MVP + (size_t)DEPTH * 512 * 512, O_AVS = O_AKS + (size_t)DEPTH * DB * WIN * 1024, O_CVS = O_AVS + (size_t)DEPTH * DB * WIN * 1024;
constexpr size_t al256(size_t x) { return (x + 255) / 256 * 256; }
constexpr size_t KD_BYTES = al256((size_t)BATCH * NH * SEQ * HD * 2), PO_BYTES = al256((size_t)MPAD * 1024 * 2), PM_BYTES = al256((size_t)MPAD * NH * 4);
constexpr size_t W_WIN = 0, W_WMKV = W_WIN + (size_t)DEPTH * INW * DM * 2, W_WOUT = W_WMKV + al256((size_t)DEPTH * 1024 * DM * 2), W_WPW = W_WOUT + al256((size_t)DEPTH * DM * MIXW * 2),
  W_XCUR = W_WPW + al256((size_t)DEPTH * CCH * CCH * 2), W_XA = W_XCUR + al256((size_t)MT * DM * 4), W_MEMB = W_XA + (size_t)MPAD * DM * 2,
  W_QB = W_MEMB + al256((size_t)512 * DM * 2),
 W_KD = W_QB + al256((size_t)MPAD * 1024 * 2), W_VD = W_KD + 3 * al256((size_t)BATCH * NH * SEQ * HD * 2), W_GAB = W_VD + 3 * al256((size_t)BATCH * NH * SEQ * HD * 2),
  W_U = W_GAB + al256((size_t)MPAD * 1024 * 2), W_GCB = W_U + al256((size_t)MPAD * CCH * 4), W_QMB = W_GCB + al256((size_t)MPAD * 512 * 2), W_GMB = W_QMB + al256((size_t)MPAD * 512 * 2),
  W_MKB = W_GMB + al256((size_t)MPAD * 512 * 2), W_MVB = W_MKB + al256((size_t)DEPTH * 512 * 512 * 2), W_CACT = W_MVB + al256((size_t)DEPTH * 512 * 512 * 2),
  W_MIX = W_CACT + al256((size_t)MPAD * CCH * 2), W_Y = W_MIX + al256((size_t)MPAD * MIXW * 2), W_YSQ = W_Y + al256((size_t)MPAD * DM * 2),     W_PO = W_YSQ + al256((size_t)MPAD * 32 * 4), W_PM = W_PO + 2 * PO_BYTES, W_PL = W_PM + 2 * PM_BYTES,
  W_BAR = W_PL + 2 * PM_BYTES, W_CMKB = W_BAR + 16384, W_CMVB = W_CMKB + al256((size_t)DEPTH * DB * NMEM * 512 * 2), W_END = W_CMVB + al256((size_t)DEPTH * DB * NMEM * 512 * 2);
#define WSP(type, off) ((type*)(KWS() + (off)))
#define WIN_L(li) (WSP(bf16_t, W_WIN) + (size_t)(((li) + DEPTH - 1) % DEPTH) * INW * DM)
#define LAS __attribute__((address_space(3)))
constexpr int LDS_MISC = 153600;
__device__ __forceinline__ int lane_id_v() { int l; asm volatile("v_mbcnt_lo_u32_b32 %0, -1, 0\n\tv_mbcnt_hi_u32_b32 %0, -1, %0" : "=v"(l)); return l; }
#define LANE_ID() lane_id_v()
#define OPAQUE_IDS int ws_ = wave_s; asm volatile("" : "+s"(ws_)); int tid_ = ws_ * 64 + LANE_ID(); asm volatile("" : "+v"(tid_)); int bid_ = blockIdx.x; asm volatile("" : "+s"(bid_)); int nb_ = gridDim.x; asm volatile("" : "+s"(nb_));
#define GW   ((int)((bid_ * NT + tid_) >> 6))
#define NGW  ((int)(nb_ * (NT / 64)))
#define GT   ((size_t)bid_ * NT + tid_)
#define NGT  ((size_t)nb_ * NT)

namespace pg8 {
#define PG8_LAS __attribute__((address_space(3)))
typedef unsigned short bf16_t;
typedef short bf16x8 __attribute__((ext_vector_type(8)));
typedef float f32x4 __attribute__((ext_vector_type(4)));
typedef unsigned u32x4 __attribute__((ext_vector_type(4)));
constexpr int BM = 256, BK = 64, HALF = 128, HTB = HALF * BK * 2  , STAGE_BYTES = 8 * HTB, NXCD = 8, WGM = 8;

__host__ __device__ __forceinline__ int lds_byte(int r, int c) { const int st = (r >> 4) * 2 + (c >> 5), rr = r & 15, cc = c & 31, ob = rr * 64 + cc * 2; return st * 1024 + (ob ^ (((ob >> 9) & 1) << 5)); }
__host__ __device__ __forceinline__ void stage_rc(int b, int& R, int& C) { const int st = b / 1024, sb = b % 1024, swz = sb ^ (((sb >> 9) & 1) << 5); R = (st >> 1) * 16 + swz / 64; C = (st & 1) * 32 + (swz % 64) / 2; }
__host__ __device__ __forceinline__ int perm32(int rho) { const int n = rho >> 4, i = rho & 15; return 8 * (i >> 2) + 4 * n + (i & 3); }

struct Unit { int pm, pn; };
struct Gemm { const bf16_t* A; const bf16_t* Bt; int M, N, K; };

struct StaticOrder {
    int nM, nN, nwg, G, c, extra;
    __host__ __device__ void init(int M, int N, int G_, int c_, int extra_ = 0) { nM = M / BM; nN = N / BM; nwg = nM * nN; G = G_; c = c_; extra = extra_; }
    __host__ __device__ bool next(int i, Unit& u) const {
        const long L = (long)i * G + c; if (L >= nwg) { const int e = (int)(L - nwg); if (e >= extra) return false; u.pm = nM + (e & 1); u.pn = nN + (e >> 1); return true; }
        int wgid = (int)L; { const int q = nwg / NXCD, r = nwg % NXCD, xcd = wgid % NXCD, off = wgid / NXCD; wgid = (xcd < r ? xcd * (q + 1) : r * (q + 1) + (xcd - r) * q) + off; }
        const int nig = WGM * nN, gid = wgid / nig, fm = gid * WGM, gsz = (nM - fm) < WGM ? (nM - fm) : WGM;
        u.pm = fm + ((wgid % nig) % gsz); u.pn = (wgid % nig) / gsz; return true;
    }
    __device__ __forceinline__ void a_ready(const Unit&) const {}
    __device__ __forceinline__ void done(const Unit&) const {}
};

__device__ __forceinline__ unsigned cvt_pk_bf16(float lo, float hi) { unsigned r; asm volatile("v_cvt_pk_bf16_f32 %0, %1, %2" : "=v"(r) : "v"(lo), "v"(hi)); return r; }
typedef float f32x2 __attribute__((ext_vector_type(2)));
template <class Epi, class Sched, bool ALIGN_EPI = false, bool SP2 = false>
__device__ __forceinline__ void gemm_phase(PG8_LAS unsigned char* lds, const Gemm g, const Sched& S, const Epi& E, int wave_s) {
    int ws_ = wave_s; asm volatile("" : "+s"(ws_)); int tid_ = ws_ * 64 + lane_id_v(); asm volatile("" : "+v"(tid_));
    const int tid = tid_, wid = __builtin_amdgcn_readfirstlane(tid >> 6), lane = tid & 63, wr = wid >> 2, wc = wid & 3, fr = lane & 15, fq = lane >> 4;
    const int K = g.K, nt = K / BK;
    unsigned voffA[2], voffB[2];
#pragma unroll
    for (int i = 0; i < 2; ++i) { int R, C; stage_rc(tid * 16 + i * 8192, R, C); const int Rb = Epi::PERM ? ((R & ~31) + perm32(R & 31)) : R;
        voffA[i] = (unsigned)(R * K + C) * 2u; voffB[i] = (unsigned)(Rb * K + C) * 2u; }
    const size_t kstep = (size_t)(BK * 2);
    const size_t hstep = (size_t)HALF * K * 2;
    const size_t tstep = 2 * hstep;
    const unsigned ldsw = (unsigned)wid * 1024u;
    const int aoff = lds_byte(wr * 64 + fr, fq * 8), boff = lds_byte(wc * 32 + fr, fq * 8);
#define PG8_SA(b, h) (((b) * 2 + (h)) * HTB)
#define PG8_SB(b, h) ((4 + (b) * 2 + (h)) * HTB)
#define PG8_STAGE(bufoff, gbase, voff) do { _Pragma("unroll") for (int _i = 0; _i < 2; ++_i) \
        __builtin_amdgcn_global_load_lds((const unsigned*)((const char*)(gbase) + (voff)[_i]), (PG8_LAS unsigned*)(lds + (bufoff) + ldsw + _i * 8192), 16, 0, 0); } while (0)
#define PG8_LDA(dst, b, h) do { _Pragma("unroll") for (int m = 0; m < 4; ++m) _Pragma("unroll") for (int k = 0; k < 2; ++k) dst[m][k] = *(const PG8_LAS bf16x8*)(lds + PG8_SA(b, h) + aoff + m * 2048 + k * 1024); } while (0)
#define PG8_LDB(dst, b, h) do { _Pragma("unroll") for (int n = 0; n < 2; ++n) _Pragma("unroll") for (int k = 0; k < 2; ++k) dst[n][k] = *(const PG8_LAS bf16x8*)(lds + PG8_SB(b, h) + boff + n * 2048 + k * 1024); } while (0)
#define PG8_MMA(ai, bj, At, Bt) do { __builtin_amdgcn_s_setprio(1); _Pragma("unroll") for (int m = 0; m < 4; ++m) _Pragma("unroll") for (int n = 0; n < 2; ++n) _Pragma("unroll") for (int k = 0; k < 2; ++k) \
        acc[ai][bj][m][n] = __builtin_amdgcn_mfma_f32_16x16x32_bf16(Bt[n][k], At[m][k], acc[ai][bj][m][n], 0, 0, 0); __builtin_amdgcn_s_setprio(0); } while (0)
#define PG8_WAIT_V(n) asm volatile("s_waitcnt vmcnt(" #n ")" ::: "memory")
#define PG8_WAIT_L(n) asm volatile("s_waitcnt lgkmcnt(" #n ")" ::: "memory")
#define PG8_BAR __builtin_amdgcn_s_barrier()
#define PG8_SCHED __builtin_amdgcn_sched_barrier(0)
    Unit cur, nxt; int ui = 0;
    if (!S.next(0, cur)) return;
    f32x4 acc[2][2][4][2];
#pragma unroll
    for (int a = 0; a < 2; ++a)
#pragma unroll
        for (int b = 0; b < 2; ++b)
#pragma unroll
            for (int m = 0; m < 4; ++m)
#pragma unroll
                for (int n = 0; n < 2; ++n) acc[a][b][m][n] = (f32x4){0.f, 0.f, 0.f, 0.f};
    bf16x8 At[4][2], B0[2][2], B1[2][2];
    const char* cA = (const char*)g.A + (size_t)cur.pm * tstep; const char* cB = (const char*)g.Bt + (size_t)cur.pn * tstep;
    S.a_ready(cur);
    if constexpr (SP2) {
        PG8_STAGE(PG8_SB(0, 0), cB, voffB); PG8_STAGE(PG8_SB(0, 1), cB + hstep, voffB); PG8_STAGE(PG8_SA(0, 0), cA, voffA); PG8_STAGE(PG8_SA(0, 1), cA + hstep, voffA);
        if (wr == 1) PG8_BAR;
        PG8_WAIT_V(2); PG8_BAR;
        PG8_STAGE(PG8_SB(1, 0), cB + kstep, voffB); PG8_STAGE(PG8_SA(1, 0), cA + kstep, voffA); PG8_STAGE(PG8_SB(1, 1), cB + hstep + kstep, voffB);
        PG8_WAIT_V(6); PG8_BAR;
    } else {
        PG8_STAGE(PG8_SB(0, 0), cB, voffB); PG8_STAGE(PG8_SA(0, 0), cA, voffA); PG8_STAGE(PG8_SB(0, 1), cB + hstep, voffB); PG8_STAGE(PG8_SA(0, 1), cA + hstep, voffA);
        if (wr == 1) PG8_BAR;
        PG8_WAIT_V(4); PG8_BAR;
        PG8_STAGE(PG8_SB(1, 0), cB + kstep, voffB); PG8_STAGE(PG8_SA(1, 0), cA + kstep, voffA); PG8_STAGE(PG8_SB(1, 1), cB + hstep + kstep, voffB);
        PG8_WAIT_V(6); PG8_BAR;
    }
    for (;;) {
        const bool has_next = S.next(ui + 1, nxt);
        const char* nA = has_next ? (const char*)g.A + (size_t)nxt.pm * tstep : cA; const char* nB = has_next ? (const char*)g.Bt + (size_t)nxt.pn * tstep : cB;
        for (int t = 0; t < nt; t += 2) {
            const bool last = (t == nt - 2);
            const char* a1 = cA + (size_t)(t + 1) * kstep;
            const char* a2 = last ? nA : cA + (size_t)(t + 2) * kstep; const char* b2 = last ? nB : cB + (size_t)(t + 2) * kstep;
            const char* a3 = a2 + kstep; const char* b3 = b2 + kstep;
            if (last && has_next) S.a_ready(nxt);
            if constexpr (SP2) {
            PG8_LDB(B0, 0, 0); PG8_LDB(B1, 0, 1); PG8_SCHED; PG8_LDA(At, 0, 0); PG8_STAGE(PG8_SA(1, 1), a1 + hstep, voffA);
            PG8_WAIT_V(8); PG8_WAIT_L(0); PG8_BAR; PG8_MMA(0, 0, At, B0); PG8_MMA(0, 1, At, B1); PG8_BAR; PG8_SCHED;
            PG8_LDA(At, 0, 1); PG8_STAGE(PG8_SB(0, 0), b2, voffB); PG8_STAGE(PG8_SB(0, 1), b2 + hstep, voffB); PG8_STAGE(PG8_SA(0, 0), a2, voffA);
            PG8_WAIT_V(8); PG8_WAIT_L(0); PG8_BAR; PG8_MMA(1, 0, At, B0); PG8_MMA(1, 1, At, B1); PG8_BAR; PG8_SCHED;
            PG8_LDB(B0, 1, 0); PG8_LDB(B1, 1, 1); PG8_SCHED; PG8_LDA(At, 1, 0); PG8_STAGE(PG8_SA(0, 1), a2 + hstep, voffA);
            PG8_WAIT_V(8); PG8_WAIT_L(0); PG8_BAR; PG8_MMA(0, 0, At, B0); PG8_MMA(0, 1, At, B1); PG8_BAR; PG8_SCHED;
            PG8_LDA(At, 1, 1); PG8_STAGE(PG8_SB(1, 0), b3, voffB); PG8_STAGE(PG8_SB(1, 1), b3 + hstep, voffB); PG8_STAGE(PG8_SA(1, 0), a3, voffA);
            PG8_WAIT_V(8); PG8_WAIT_L(0); PG8_BAR; PG8_MMA(1, 0, At, B0); PG8_MMA(1, 1, At, B1); PG8_BAR; PG8_SCHED;
            } else {
            PG8_LDB(B0, 0, 0); PG8_SCHED; PG8_LDA(At, 0, 0); PG8_STAGE(PG8_SA(1, 1), a1 + hstep, voffA);
            PG8_WAIT_L(8); PG8_BAR; PG8_WAIT_L(0); PG8_MMA(0, 0, At, B0); PG8_BAR; PG8_SCHED;
            PG8_LDB(B1, 0, 1); PG8_STAGE(PG8_SB(0, 0), b2, voffB);
            PG8_BAR; PG8_WAIT_L(0); PG8_MMA(0, 1, At, B1); PG8_BAR;
            PG8_LDA(At, 0, 1); PG8_STAGE(PG8_SA(0, 0), a2, voffA);
            PG8_BAR; PG8_WAIT_L(0); PG8_MMA(1, 0, At, B0); PG8_BAR; PG8_SCHED;
            PG8_STAGE(PG8_SB(0, 1), b2 + hstep, voffB);
            PG8_WAIT_V(6); PG8_BAR; PG8_MMA(1, 1, At, B1); PG8_BAR;
            PG8_LDB(B0, 1, 0); PG8_SCHED; PG8_LDA(At, 1, 0); PG8_STAGE(PG8_SA(0, 1), a2 + hstep, voffA);
            PG8_WAIT_L(8); PG8_BAR; PG8_WAIT_L(0); PG8_MMA(0, 0, At, B0); PG8_BAR; PG8_SCHED;
            PG8_LDB(B1, 1, 1); PG8_STAGE(PG8_SB(1, 0), b3, voffB);
            PG8_BAR; PG8_WAIT_L(0); PG8_MMA(0, 1, At, B1); PG8_BAR;
            PG8_LDA(At, 1, 1); PG8_STAGE(PG8_SA(1, 0), a3, voffA);
            PG8_BAR; PG8_WAIT_L(0); PG8_MMA(1, 0, At, B0); PG8_BAR; PG8_SCHED;
            PG8_STAGE(PG8_SB(1, 1), b3 + hstep, voffB);
            PG8_WAIT_V(6); PG8_BAR; PG8_MMA(1, 1, At, B1); PG8_BAR;
            }
        }
        if constexpr (ALIGN_EPI) { if (wr == 0) PG8_BAR; }
        if constexpr (!Epi::AFTER_DRAIN) { E(acc, cur, wr, wc, fr, fq); S.done(cur); }
        if (!has_next) break;
#pragma unroll
        for (int a = 0; a < 2; ++a)
#pragma unroll
            for (int b = 0; b < 2; ++b)
#pragma unroll
                for (int m = 0; m < 4; ++m)
#pragma unroll
                    for (int n = 0; n < 2; ++n) acc[a][b][m][n] = (f32x4){0.f, 0.f, 0.f, 0.f};
        cur = nxt; cA = nA; cB = nB; ++ui;
        if constexpr (ALIGN_EPI) { if (wr == 1) PG8_BAR; }
    }
    PG8_WAIT_V(0);
    if constexpr (!ALIGN_EPI) { if (wr == 0) PG8_BAR; }
    PG8_BAR;
    if constexpr (Epi::AFTER_DRAIN) { E.fused(acc, cur, wr, wc, fr, fq, lds, wid, lane); S.done(cur); }
#undef PG8_SA
#undef PG8_SB
#undef PG8_STAGE
#undef PG8_LDA
#undef PG8_LDB
#undef PG8_MMA
#undef PG8_WAIT_V
#undef PG8_WAIT_L
#undef PG8_BAR
#undef PG8_SCHED
}
}

namespace pg8 {
struct EpiMulti {
    static constexpr bool PERM = true, AFTER_DRAIN = false;
    int mode, li;
    static __device__ __forceinline__ v4u pack8(f32x4 a, f32x4 b) { v4u w; w.x = cvt_pk_bf16(a[0], a[1]); w.y = cvt_pk_bf16(a[2], a[3]); w.z = cvt_pk_bf16(b[0], b[1]); w.w = cvt_pk_bf16(b[2], b[3]); return w; }
    __device__ __forceinline__ void operator()(const f32x4 (&acc)[2][2][4][2], const Unit& u, int wr, int wc, int fr, int fq) const {
        const int rt = u.pm * BM + wr * 64 + fr, ct = wc * 32 + 8 * fq;
        unsigned char* ws = KWS();
        if (mode == 1 && u.pm < MPAD / BM) {
            const int pn = u.pn;
            if (pn >= 16 && pn < 20) {
                float* U = (float*)(ws + W_U); float* out = KOUT(); const int cb = (pn - 16) * 128 + ct;
#pragma unroll
                for (int ai = 0; ai < 2; ++ai)
#pragma unroll
                    for (int m = 0; m < 4; ++m) { const int row = rt + ai * HALF + m * 16; f32x4 r0, r1;
#pragma unroll
                        for (int e = 0; e < 4; ++e) { r0[e] = acc[ai][0][m][0][e] * sigmoidf(acc[ai][1][m][0][e]); r1[e] = acc[ai][0][m][1][e] * sigmoidf(acc[ai][1][m][1][e]); }
                        float* d = U + (size_t)row * CCH + cb; *(f32x4*)d = r0; *(f32x4*)(d + 4) = r1;
                        if (row < MP) { const int s = row & (SEQ - 1); if (s >= SEQ - 30) { float* o = out + O_CVP + ((size_t)(li * BATCH + (row >> 12)) * 30 + (s - (SEQ - 30))) * CCH + cb; *(f32x4*)o = r0; *(f32x4*)(o + 4) = r1; } }
                        else if (row < MT) { const int b = (row - MP) >> 3, t = (row - MP) & 7; float* o = out + O_CVS + ((size_t)(li * DB + b) * 30 + 22 + t) * CCH + cb; *(f32x4*)o = r0; *(f32x4*)(o + 4) = r1; } }
            } else {
                size_t dsto; int ld, cofs, act; size_t fo_p = 0, fo_s = 0; bool f32o = false;
                if (pn < 4) { dsto = W_QB; ld = 1024; cofs = pn * 256; act = 1; }
                else if (pn < 8) { dsto = W_KD; ld = 0; cofs = (pn - 4) * 256; act = 0; f32o = true; fo_p = O_AKP; fo_s = O_AKS; }
                else if (pn < 12) { dsto = W_VD; ld = 0; cofs = (pn - 8) * 256; act = 0; f32o = true; fo_p = O_AVP; fo_s = O_AVS; }
                else if (pn < 16) { dsto = W_GAB; ld = 1024; cofs = (pn - 12) * 256; act = 2; }
                else if (pn < 22) { dsto = W_GCB; ld = 512; cofs = (pn - 20) * 256; act = 2; }
                else if (pn < 24) { dsto = W_QMB; ld = 512; cofs = (pn - 22) * 256; act = 1; }
                else { dsto = W_GMB; ld = 512; cofs = (pn - 24) * 256; act = 2; }
                bf16_t* D = (bf16_t*)(ws + dsto); float* out = KOUT();
#pragma unroll
                for (int ai = 0; ai < 2; ++ai)
#pragma unroll
                    for (int m = 0; m < 4; ++m) { const int row = rt + ai * HALF + m * 16;
#pragma unroll
                        for (int bj = 0; bj < 2; ++bj) { f32x4 v0 = acc[ai][bj][m][0], v1 = acc[ai][bj][m][1]; const int col = cofs + bj * HALF + ct;
                            if (f32o) {
                                if (row < MP) { const int s = row & (SEQ - 1); if (s >= SEQ - WIN) { float* o = out + fo_p + ((size_t)(li * BATCH + (row >> 12)) * WIN + (s - (SEQ - WIN))) * 1024 + col; *(f32x4*)o = v0; *(f32x4*)(o + 4) = v1; } }
                                else if (row < MT) { const int b = (row - MP) >> 3, t = (row - MP) & 7; float* o = out + fo_s + ((size_t)(li * DB + b) * WIN + (WIN - DS) + t) * 1024 + col; *(f32x4*)o = v0; *(f32x4*)(o + 4) = v1; } }
                            if (act == 1) { v0 = v0 * QS; v1 = v1 * QS; }
                            else if (act == 2) {
#pragma unroll
                                for (int e = 0; e < 4; ++e) { v0[e] = silu(v0[e]); v1[e] = silu(v1[e]); } }
                            if (ld) *(v4u*)(D + (size_t)row * ld + col) = pack8(v0, v1);
                            else if (row < MP) {
                                const v4u w = pack8(v0, v1); const int bh = (row >> 12) * NH + (col >> 7), pos = row & (SEQ - 1), dh = col & 127;
                                *(v4u*)(D + ((size_t)bh * SEQ + pos) * HD + dh) = w; } } }
            }
        } else if (mode == 2) {
            bf16_t* Y = (bf16_t*)(ws + W_Y); float* YSQ = (float*)(ws + W_YSQ);
#pragma unroll
            for (int ai = 0; ai < 2; ++ai)
#pragma unroll
                for (int m = 0; m < 4; ++m) { const int row = rt + ai * HALF + m * 16; float s = 0.f;
#pragma unroll
                    for (int bj = 0; bj < 2; ++bj) { const f32x4 v0 = acc[ai][bj][m][0], v1 = acc[ai][bj][m][1];
                        *(v4u*)(Y + (size_t)row * DM + u.pn * BM + bj * HALF + ct) = pack8(v0, v1);
                        s += (v0[0] * v0[0] + v0[1] * v0[1]) + (v0[2] * v0[2] + v0[3] * v0[3]) + (v1[0] * v1[0] + v1[1] * v1[1]) + (v1[2] * v1[2] + v1[3] * v1[3]); }
                    s += __shfl_xor(s, 16); s += __shfl_xor(s, 32);
                    if (fq == 0) YSQ[(size_t)row * 32 + u.pn * 4 + wc] = s; }
        } else if (mode == 3) {
            const bf16_t* G = (const bf16_t*)(ws + W_GCB); bf16_t* MIX = (bf16_t*)(ws + W_MIX);
#pragma unroll
            for (int ai = 0; ai < 2; ++ai)
#pragma unroll
                for (int m = 0; m < 4; ++m) { const int row = rt + ai * HALF + m * 16;
#pragma unroll
                    for (int bj = 0; bj < 2; ++bj) { const int col = u.pn * BM + bj * HALF + ct; const v4u g = *(const v4u*)(G + (size_t)row * CCH + col);
                        f32x4 v0 = acc[ai][bj][m][0], v1 = acc[ai][bj][m][1];
                        v0[0] *= bflo(g.x); v0[1] *= bfhi(g.x); v0[2] *= bflo(g.y); v0[3] *= bfhi(g.y); v1[0] *= bflo(g.z); v1[1] *= bfhi(g.z); v1[2] *= bflo(g.w); v1[3] *= bfhi(g.w);
                        *(v4u*)(MIX + (size_t)row * MIXW + 1024 + col) = pack8(v0, v1); } }
        } else {
            const int pnm = u.pn - INW / BM, layer = pnm >> 2, q = pnm & 3, isv = q >> 1; float* out = KOUT() + (isv ? O_MVP : O_MKP); bf16_t* D = (bf16_t*)(ws + (isv ? W_MVB : W_MKB));
#pragma unroll
            for (int ai = 0; ai < 2; ++ai)
#pragma unroll
                for (int m = 0; m < 4; ++m) { const int row = rt - MPAD + ai * HALF + m * 16;
#pragma unroll
                    for (int bj = 0; bj < 2; ++bj) { const size_t o = ((size_t)layer * 512 + row) * 512 + (q & 1) * 256 + bj * HALF + ct; const f32x4 v0 = acc[ai][bj][m][0], v1 = acc[ai][bj][m][1];
                        *(f32x4*)(out + o) = v0; *(f32x4*)(out + o + 4) = v1; *(v4u*)(D + o) = pack8(v0, v1); } }
        }
    }
};
}
__device__ __forceinline__ void transpose_item(const float* __restrict__ W, const float* __restrict__ g, int K, int N, bf16_t* __restrict__ WT, float* scr, int item, int lane, bool glu) {
    const int nblk = N / 32, kb = item / nblk, nb = item % nblk, k0 = 64 * kb, n0 = 32 * nb;
    int d0 = n0;
    if (glu && n0 >= 4096 && n0 < 5120) { const int isg = n0 >= 4608, r = n0 - (isg ? 4608 : 4096); d0 = 4096 + (r >> 7) * 256 + isg * 128 + (r & 127); }
    float wv[32];
#pragma unroll
    for (int i = 0; i < 32; ++i) wv[i] = __builtin_nontemporal_load(W + (size_t)(k0 + 2 * i + (lane >> 5)) * N + n0 + (lane & 31));
#pragma unroll
    for (int i = 0; i < 32; ++i) { const int kk = 2 * i + (lane >> 5); float v = wv[i]; if (g) v *= g[k0 + kk]; scr[kk * 33 + (lane & 31)] = v; }
    asm volatile("s_waitcnt lgkmcnt(0)" ::: "memory");
    const int c = lane & 7;
#pragma unroll
    for (int j = 0; j < 4; ++j) { const int n = (lane >> 3) + 8 * j; const float* s = scr + (8 * c) * 33 + n;
        v4u o; o.x = pk2(s[0 * 33], s[1 * 33]); o.y = pk2(s[2 * 33], s[3 * 33]); o.z = pk2(s[4 * 33], s[5 * 33]); o.w = pk2(s[6 * 33], s[7 * 33]);
        *(v4u*)(WT + (size_t)(d0 + n) * K + k0 + 8 * c) = o; }
    asm volatile("s_waitcnt lgkmcnt(0)" ::: "memory");
}

constexpr int I_IN = (DM / 64) * (INW / 32), I_OUT = (MIXW / 64) * (DM / 32), I_PW = (CCH / 64) * (CCH / 32), I_MKV = (DM / 64) * (1024 / 32);
constexpr int W_ITEMS = I_IN + I_OUT + I_PW;
constexpr size_t CH4 = (size_t)(WIN - DS) * 1024 / 4;
constexpr int C_ITEMS = (int)((size_t)DEPTH * DB * CH4 / 1024);
static_assert((size_t)C_ITEMS * 1024 == (size_t)DEPTH * DB * CH4, "cache shift items");
__device__ __forceinline__ void w_item(int L, int r, float* scr, int lane) {
  if (r < I_IN) { transpose_item(KIN(I_WIN) + (size_t)L * DM * INW, KIN(I_GPRE) + L * DM, DM, INW, WIN_L(L), scr, r, lane, true); return; } r -= I_IN;
  if (r < I_OUT) { transpose_item(KIN(I_WOUT) + (size_t)L * MIXW * DM, nullptr, MIXW, DM, WSP(bf16_t, W_WOUT) + (size_t)L * DM * MIXW, scr, r, lane, false); return; } r -= I_OUT;
  transpose_item(KIN(I_WPW) + (size_t)L * CCH * CCH, nullptr, CCH, CCH, WSP(bf16_t, W_WPW) + (size_t)L * CCH * CCH, scr, r, lane, false);
}
__device__ __forceinline__ void c_item(int q, int lane) {
  const f4* ck = (const f4*)KIN(I_CK); const f4* cv = (const f4*)KIN(I_CV); f4* ok = (f4*)(KOUT() + O_AKS); f4* ov = (f4*)(KOUT() + O_AVS);
  const size_t i0 = (size_t)q * 1024; const size_t lb = i0 / CH4, r0 = i0 % CH4;
  const size_t so = lb * ((size_t)WIN * 256) + DS * 256 + r0 + lane, dof = lb * ((size_t)WIN * 256) + r0 + lane;
  f4 a[8], b[8];
#pragma unroll
  for (int h = 0; h < 2; ++h) {
#pragma unroll
    for (int j = 0; j < 8; ++j) { a[j] = __builtin_nontemporal_load(ck + so + (h * 8 + j) * 64); b[j] = __builtin_nontemporal_load(cv + so + (h * 8 + j) * 64); }
#pragma unroll
    for (int j = 0; j < 8; ++j) { __builtin_nontemporal_store(a[j], ok + dof + (h * 8 + j) * 64); __builtin_nontemporal_store(b[j], ov + dof + (h * 8 + j) * 64); } }
}
static_assert(CH4 % 1024 == 0, "cache shift item size");
constexpr int NSLOT_W = 3312;
__device__ __forceinline__ void ph_filler(int li, int vs0, int nv, int nvs, float* lds_f, int wave_s) {
  OPAQUE_IDS
  const int lane = tid_ & 63; float* scr = lds_f + wave_s * (64 * 33);
  constexpr int CQ = C_ITEMS / DEPTH;
  for (int v = vs0; v < vs0 + nv; ++v) {
    if (li + 1 < DEPTH) for (int r = v; r < W_ITEMS; r += nvs) w_item(li + 1, r, scr, lane);
#ifndef COPY_IN_PROLOGUE
    for (int q = v; q < CQ; q += nvs) c_item(li * CQ + q, lane);
#endif
  }
}
static_assert(C_ITEMS % DEPTH == 0, "cache shift quarter");

__device__ __forceinline__ void ph_prologue(float* lds_f, int wave_s) {
  OPAQUE_IDS
  const int lane = tid_ & 63, wave = tid_ >> 6;
  float* scr = lds_f + wave * (64 * 33);
  for (int it = GW; it < W_ITEMS + DEPTH * I_MKV; it += NGW) {
    if (it < W_ITEMS) w_item(0, it, scr, lane);
    else { const int r = it - W_ITEMS, L = r / I_MKV; transpose_item(KIN(I_WMKV) + (size_t)L * DM * 1024, nullptr, DM, 1024, WSP(bf16_t, W_WMKV) + (size_t)L * 1024 * DM, scr, r % I_MKV, lane, false); }
  }
#ifdef COPY_IN_PROLOGUE
  for (int q = GW; q < C_ITEMS; q += NGW) c_item(q, lane);
#endif
  { const float* mem_prompt = KIN(I_MEM); bf16_t* memb = WSP(bf16_t, W_MEMB);
    for (size_t i = GT; i < (size_t)512 * DM; i += NGT) memb[i] = (bf16_t)f2bf(mem_prompt[i]); }
  {
    const f4* ck = (const f4*)KIN(I_CMK); const f4* cv = (const f4*)KIN(I_CMV); unsigned long long* ok = WSP(unsigned long long, W_CMKB); unsigned long long* ov = WSP(unsigned long long, W_CMVB);
    for (size_t i = GT; i < (size_t)DEPTH * DB * NMEM * 512 / 4; i += NGT) { const f4 a = ck[i], b = cv[i];
      ok[i] = (unsigned long long)pk2(a[0], a[1]) | ((unsigned long long)pk2(a[2], a[3]) << 32); ov[i] = (unsigned long long)pk2(b[0], b[1]) | ((unsigned long long)pk2(b[2], b[3]) << 32); } }
  {
    const float* xp = KIN(I_XP); const float* xs = KIN(I_XS); bf16_t* xa = WSP(bf16_t, W_XA);
    for (int w = MT + GW; w < MPAD; w += NGW) { unsigned long long* o = (unsigned long long*)(xa + (size_t)w * DM); for (int j = 0; j < 8; ++j) o[lane + 64 * j] = 0ull; }
#define PR_XR(w) ((const f4*)(((w) < MP) ? xp + (size_t)(w) * DM : xs + (size_t)((w) - MP) * DM))
    int w = GW;
    if (w < MT) {
      f4 v[8];
#pragma unroll
      for (int j = 0; j < 8; ++j) v[j] = PR_XR(w)[lane + 64 * j];
      for (;;) {
        const int wn = w + NGW; const bool more = wn < MT; f4 vn[8];
        if (more) {
#pragma unroll
          for (int j = 0; j < 8; ++j) vn[j] = PR_XR(wn)[lane + 64 * j]; }
        float s = 0.f;
#pragma unroll
        for (int j = 0; j < 8; ++j) s += (v[j][0] * v[j][0] + v[j][1] * v[j][1]) + (v[j][2] * v[j][2] + v[j][3] * v[j][3]);
        const float rstd = rsqrtf(wave_sum(s) / DM + EPS); unsigned long long* o = (unsigned long long*)(xa + (size_t)w * DM); unsigned long long* xr0 = (unsigned long long*)(WSP(bf16_t, W_XCUR) + (size_t)w * DM);
#pragma unroll
        for (int j = 0; j < 8; ++j) { o[lane + 64 * j] = (unsigned long long)pk2(v[j][0] * rstd, v[j][1] * rstd) | ((unsigned long long)pk2(v[j][2] * rstd, v[j][3] * rstd) << 32);
          xr0[lane + 64 * j] = (unsigned long long)pk2(v[j][0], v[j][1]) | ((unsigned long long)pk2(v[j][2], v[j][3]) << 32); }
        if (!more) break;
        w = wn;
#pragma unroll
        for (int j = 0; j < 8; ++j) v[j] = vn[j];
      }
    }
#undef PR_XR
  }
  {
    const float* st = KIN(I_ST); float* o = KOUT() + O_CVS;
    for (size_t i = GT; i < (size_t)DEPTH * DB * 22 * CCH; i += NGT) { const size_t lb = i / (22 * CCH), r = i % (22 * CCH); o[lb * 30 * CCH + r] = st[lb * 30 * CCH + 8 * CCH + r]; } }
}

namespace att {
using bf16x8 = __attribute__((ext_vector_type(8))) short;
using s16x4  = __attribute__((ext_vector_type(4))) short;
using f32x16 = __attribute__((ext_vector_type(16))) float;
using u32x4  = __attribute__((ext_vector_type(4))) unsigned;
using f32x8  = __attribute__((ext_vector_type(8))) float;
constexpr int TBL_N = 192, TBL_O = 32, LDS_TBL = 131072, LDS_WSF = LDS_TBL + 3 * NH * TBL_N * 4;
static_assert(LDS_WSF + 8 * 128 * 4 <= LDS_MISC && LDS_MISC + 64 <= LDS_BYTES, "attention LDS map");
constexpr float THR = 4.f;
#define KSWZ(row, colB) ((row) * 256 + ((colB) ^ (((row) & 7) << 4)))
#define SBAR() __builtin_amdgcn_sched_barrier(0)
__device__ __forceinline__ int crow(int r, int hi) { return (r & 3) + 8 * (r >> 2) + 4 * hi; }
__device__ __forceinline__ unsigned cvtpk(float lo, float hi) { unsigned r; asm volatile("v_cvt_pk_bf16_f32 %0, %1, %2" : "=v"(r) : "v"(lo), "v"(hi)); return r; }
__device__ __forceinline__ int v_st(int k, int c) { const int kk = (k & ~0xC) | ((k & 4) << 1) | ((k & 8) >> 1); return ((kk >> 3) * 4 + (c >> 5)) * 512 + ((kk & 7) * 32 + (c & 31)) * 2; }
__device__ __forceinline__ int v_rd_base(int lane) { return ((lane & 3) << 3) | (((lane >> 2) & 3) << 6) | (((lane >> 4) & 1) << 5) | (((lane >> 5) & 1) << 8); }
constexpr int v_rd_off(int d0, int ks, int half) { return d0 * 512 + ks * 4096 + half * 2048; }
template <int OFF> __device__ __forceinline__ s16x4 tr_read(int vb) { s16x4 r; asm volatile("ds_read_b64_tr_b16 %0, %1 offset:%2" : "=&v"(r) : "v"(vb), "i"(OFF) : "memory"); return r; }
template <int D0> __device__ __forceinline__ void pv_one(f32x16& od, int vb, bf16x8 pa0, bf16x8 pa1) {
  const s16x4 l0 = tr_read<v_rd_off(D0, 0, 0)>(vb), h0 = tr_read<v_rd_off(D0, 0, 1)>(vb), l1 = tr_read<v_rd_off(D0, 1, 0)>(vb), h1 = tr_read<v_rd_off(D0, 1, 1)>(vb);
  asm volatile("s_waitcnt lgkmcnt(0)" ::: "memory"); SBAR();
#define PK(L, H) (bf16x8){L[0], L[1], L[2], L[3], H[0], H[1], H[2], H[3]}
  od = __builtin_amdgcn_mfma_f32_32x32x16_bf16(pa0, PK(l0, h0), od, 0, 0, 0);
  od = __builtin_amdgcn_mfma_f32_32x32x16_bf16(pa1, PK(l1, h1), od, 0, 0, 0);
#undef PK
}
__device__ __forceinline__ bf16x8 tobf(f32x8 x) { u32x4 w = {cvtpk(x[0], x[1]), cvtpk(x[2], x[3]), cvtpk(x[4], x[5]), cvtpk(x[6], x[7])}; return __builtin_bit_cast(bf16x8, w); }

struct Task {
  int row0, rstep, head;
  const bf16_t *Kb, *Vb;
  const float *Kc, *Vc, *Kn, *Vn;
  int q0, t0, pat, pend, nrows, rs;
};
template <bool SAMPLE, bool CROSS, int OUT>
__device__ __forceinline__ void wave_task(char* lds, int wave, int lane_in, const Task& T) {
  int lane = lane_in; asm volatile("" : "+v"(lane));
  const int r32 = lane & 31, hi = lane >> 5, rsub = lane >> 4, ch = lane & 15;
  char* Kl = lds + wave * 16384; char* Vl = Kl + 8192;
  float* wsf = (float*)(lds + LDS_WSF) + wave * 128;
  const int vb = (int)(unsigned)(uintptr_t)Vl + v_rd_base(lane);
  bf16x8 qr[8];
  { const bf16_t* Q0 = CROSS ? WSP(bf16_t, W_QMB) + (size_t)T.row0 * 512 + T.head * HD : WSP(bf16_t, W_QB) + (size_t)T.row0 * 1024 + T.head * HD; const int qstride = T.rstep * (CROSS ? 512 : 1024);
#pragma unroll
    for (int d0 = 0; d0 < 8; ++d0) qr[d0] = *(const bf16x8*)(Q0 + r32 * qstride + d0 * 16 + hi * 8); }
  float m_reg = -1e30f, l_reg = 0.f; f32x16 o[4] = {};
  const int RS = CROSS ? 1024 : T.rs;
  bf16x8 kst[8], vst[8];
  const int loff = rsub * RS + ch * 16;
#define LOAD_T(t) do { const char* kp_ = (const char*)T.Kb + (size_t)(t) * (32 * RS) + loff; const char* vp_ = (const char*)T.Vb + (size_t)(t) * (32 * RS) + loff; \
    _Pragma("unroll") for (int c = 0; c < 8; ++c) { kst[c] = *(const bf16x8*)(kp_ + c * 4 * RS); vst[c] = *(const bf16x8*)(vp_ + c * 4 * RS); } } while (0)
#define WRITE_T() do { _Pragma("unroll") for (int c = 0; c < 8; ++c) { *(bf16x8*)(Kl + KSWZ(4 * c + rsub, ch * 16)) = kst[c]; *(bf16x8*)(Vl + v_st(4 * c + rsub, ch * 8)) = vst[c]; } } while (0)
#define DIRECT_TILE(d, t) do { _Pragma("unroll") for (int c = 0; c < 8; ++c) { const int row = 4 * c + rsub; int pos = T.q0 + (32 * (t) + row - 128) * (d); pos = pos < 0 ? 0 : (pos > WIN + DS - 1 ? WIN + DS - 1 : pos); \
      const float* kr = (CROSS || pos < WIN) ? T.Kc + (size_t)pos * (CROSS ? 512 : 1024) : T.Kn + (size_t)(pos - DS) * 1024; const float* vr = (CROSS || pos < WIN) ? T.Vc + (size_t)pos * (CROSS ? 512 : 1024) : T.Vn + (size_t)(pos - DS) * 1024; \
      const f32x8 kf = *(const f32x8*)(kr + ch * 8), vf = *(const f32x8*)(vr + ch * 8); *(bf16x8*)(Kl + KSWZ(row, ch * 16)) = tobf(kf); *(bf16x8*)(Vl + v_st(row, ch * 8)) = tobf(vf); if ((c & 3) == 3) SBAR(); } } while (0)
  constexpr int NTL = CROSS ? NMEM / 32 : 5;
  int pi = T.pat, t = SAMPLE ? 0 : T.t0;
  if constexpr (!SAMPLE) LOAD_T(t);
  for (;;) {
    if constexpr (!SAMPLE) WRITE_T();
    else { if constexpr (CROSS) { const int q0s = 128; (void)q0s; }
           const int d = CROSS ? 1 : (pi == 0 ? 1 : pi == 1 ? 4 : 16); DIRECT_TILE(d, t); }
    int pin = pi, tn = t + 1;
    if (tn >= NTL) { tn = 0; pin = pi + 1; }
    const bool more = (SAMPLE && !CROSS) ? (pin < T.pend) : (tn != 0);
    if constexpr (!SAMPLE) { if (more) LOAD_T(tn); }
    f32x16 p0 = {};
#pragma unroll
    for (int d0 = 0; d0 < 8; ++d0) { const bf16x8 a = *(const bf16x8*)(Kl + KSWZ(r32, (d0 * 16 + hi * 8) * 2)); p0 = __builtin_amdgcn_mfma_f32_32x32x16_bf16(a, qr[d0], p0, 0, 0, 0); }
    if constexpr (!CROSS) { const float* tp = (const float*)(lds + LDS_TBL) + (pi * NH + T.head) * TBL_N + TBL_O + 32 * t + 4 * hi - (SAMPLE ? 0 : r32);
#pragma unroll
      for (int r = 0; r < 16; ++r) p0[r] += tp[(r & 3) + 8 * (r >> 2)]; }
    float pmax = p0[0];
#pragma unroll
    for (int r = 1; r < 16; ++r) pmax = fmaxf(pmax, p0[r]);
    { auto rr = __builtin_amdgcn_permlane32_swap(__float_as_uint(pmax), __float_as_uint(pmax), false, false); pmax = fmaxf(__uint_as_float(rr[0]), __uint_as_float(rr[1])); }
    float alpha = 1.f;
    if (!__all(pmax - m_reg <= THR)) { const float mn = fmaxf(m_reg, pmax); alpha = __builtin_amdgcn_exp2f(m_reg - mn); m_reg = mn;
      if (hi == 0) wsf[r32] = alpha; asm volatile("s_waitcnt lgkmcnt(0)" ::: "memory");
#pragma unroll
      for (int d = 0; d < 4; ++d)
#pragma unroll
        for (int r = 0; r < 16; ++r) o[d][r] *= wsf[crow(r, hi)]; }
    float ps = 0.f;
#pragma unroll
    for (int r = 0; r < 16; ++r) { p0[r] = __builtin_amdgcn_exp2f(p0[r] - m_reg); ps += p0[r]; }
    { auto rr = __builtin_amdgcn_permlane32_swap(__float_as_uint(ps), __float_as_uint(ps), false, false); ps = __uint_as_float(rr[0]) + __uint_as_float(rr[1]); }
    l_reg = l_reg * alpha + ps;
    bf16x8 pa0, pa1;
#define PK4(PP, BASE, OUT_) do { unsigned a0 = cvtpk(PP[BASE + 0], PP[BASE + 1]), a1 = cvtpk(PP[BASE + 2], PP[BASE + 3]), b0 = cvtpk(PP[BASE + 4], PP[BASE + 5]), b1 = cvtpk(PP[BASE + 6], PP[BASE + 7]); \
    auto r0 = __builtin_amdgcn_permlane32_swap(a0, b0, false, false); auto r1 = __builtin_amdgcn_permlane32_swap(a1, b1, false, false); \
    u32x4 w = {r0[0], r1[0], r0[1], r1[1]}; OUT_ = __builtin_bit_cast(bf16x8, w); } while (0)
    PK4(p0, 0, pa0); PK4(p0, 8, pa1);
#undef PK4
    SBAR();
    pv_one<0>(o[0], vb, pa0, pa1); pv_one<1>(o[1], vb, pa0, pa1); pv_one<2>(o[2], vb, pa0, pa1); pv_one<3>(o[3], vb, pa0, pa1);
    if (!more) break;
    pi = pin; t = tn;
  }
#undef LOAD_T
#undef WRITE_T
#undef DIRECT_TILE
  int lane_e = lane; asm volatile("" : "+v"(lane_e)); const int r32e = lane_e & 31, hie = lane_e >> 5;
  float fa = __builtin_amdgcn_rcpf(l_reg), fb = 0.f, fc = 0.f;
  const int nrows = T.nrows, rstep = T.rstep;
  if constexpr (OUT == 1) { if (hie == 0 && r32e < nrows) { float* Pm = (float*)((char*)WSP(float, W_PM) + T.pat * PM_BYTES) + (size_t)T.row0 * NH + T.head; float* Pl = (float*)((char*)WSP(float, W_PL) + T.pat * PM_BYTES) + (size_t)T.row0 * NH + T.head;
      Pm[r32e * rstep * NH] = m_reg; Pl[r32e * rstep * NH] = l_reg; } }
  if constexpr (OUT == 2) { const float* Pm = WSP(float, W_PM) + (size_t)T.row0 * NH + T.head; const float* Pl = WSP(float, W_PL) + (size_t)T.row0 * NH + T.head; const int po = r32e * rstep * NH;
    const float m1 = Pm[po], l1 = Pl[po], m2 = Pm[PM_BYTES / 4 + po], l2 = Pl[PM_BYTES / 4 + po]; const float M = fmaxf(m_reg, fmaxf(m1, m2));
    const float a = __builtin_amdgcn_exp2f(m_reg - M), a1 = __builtin_amdgcn_exp2f(m1 - M) * l1, a2 = __builtin_amdgcn_exp2f(m2 - M) * l2; const float inv = __builtin_amdgcn_rcpf(l_reg * a + a1 + a2); fa = a * inv; fb = a1 * inv; fc = a2 * inv; }
  if (hie == 0) { wsf[r32e] = fa; wsf[32 + r32e] = fb; wsf[64 + r32e] = fc; } asm volatile("s_waitcnt lgkmcnt(0)" ::: "memory");
  const int rse = lane_e >> 4, che = lane_e & 15;
  bf16_t* Po = (bf16_t*)((char*)WSP(bf16_t, W_PO) + (OUT == 1 ? T.pat : 0) * PO_BYTES) + (size_t)T.row0 * 1024 + T.head * HD + che * 8; const int pstride = rstep * 1024;
  bf16_t* Mx = WSP(bf16_t, W_MIX) + (size_t)T.row0 * MIXW + (CROSS ? 1536 : 0) + T.head * HD + che * 8; const int mstride = rstep * MIXW;
  const bf16_t* Gx = (CROSS ? WSP(bf16_t, W_GMB) + (size_t)T.row0 * 512 + T.head * HD : WSP(bf16_t, W_GAB) + (size_t)T.row0 * 1024 + T.head * HD) + che * 8; const int gstride = rstep * (CROSS ? 512 : 1024);
  v4u gq[8], p1q[8], p2q[8];
  if constexpr (OUT != 1) {
#pragma unroll
    for (int c = 0; c < 8; ++c) { const int row = 4 * c + rse; if (row < nrows) { gq[c] = *(const v4u*)(Gx + row * gstride);
        if constexpr (OUT == 2) { p1q[c] = *(const v4u*)(Po + row * pstride); p2q[c] = *(const v4u*)(Po + PO_BYTES / 2 + row * pstride); } } } }
  float* so = (float*)Kl;
#pragma unroll
  for (int r = 0; r < 16; ++r) { const int orow = crow(r, hie); const float ra = wsf[orow];
#pragma unroll
    for (int d0 = 0; d0 < 4; ++d0) so[orow * 128 + d0 * 32 + r32e] = o[d0][r] * ra; }
  asm volatile("s_waitcnt lgkmcnt(0)" ::: "memory");
#pragma unroll
  for (int c = 0; c < 8; ++c) { const int row = 4 * c + rse;
    if (row < nrows) {
      f4 x0 = *(const f4*)(so + row * 128 + che * 8), x1 = *(const f4*)(so + row * 128 + che * 8 + 4);
      if constexpr (OUT == 1) { v4u w; w.x = pk2(x0[0], x0[1]); w.y = pk2(x0[2], x0[3]); w.z = pk2(x1[0], x1[1]); w.w = pk2(x1[2], x1[3]); *(v4u*)(Po + row * pstride) = w; }
      else {
        if constexpr (OUT == 2) { const float rb = wsf[32 + row], rc = wsf[64 + row]; const v4u p1 = p1q[c], p2 = p2q[c];
          x0[0] += bflo(p1.x) * rb + bflo(p2.x) * rc; x0[1] += bfhi(p1.x) * rb + bfhi(p2.x) * rc; x0[2] += bflo(p1.y) * rb + bflo(p2.y) * rc; x0[3] += bfhi(p1.y) * rb + bfhi(p2.y) * rc;
          x1[0] += bflo(p1.z) * rb + bflo(p2.z) * rc; x1[1] += bfhi(p1.z) * rb + bfhi(p2.z) * rc; x1[2] += bflo(p1.w) * rb + bflo(p2.w) * rc; x1[3] += bfhi(p1.w) * rb + bfhi(p2.w) * rc; }
        const v4u g = gq[c];
        v4u w; w.x = pk2(x0[0] * bflo(g.x), x0[1] * bfhi(g.x)); w.y = pk2(x0[2] * bflo(g.y), x0[3] * bfhi(g.y)); w.z = pk2(x1[0] * bflo(g.z), x1[1] * bfhi(g.z)); w.w = pk2(x1[2] * bflo(g.w), x1[3] * bfhi(g.w));
        *(v4u*)(Mx + row * mstride) = w; } } }
  asm volatile("s_waitcnt lgkmcnt(0)" ::: "memory");
}
#undef KSWZ
#undef SBAR
}

__device__ __forceinline__ void build_bias_tables(char* lds, int wave_s) {
  OPAQUE_IDS
  const float* rel_bias = KIN(I_RB); float* tbl = (float*)(lds + att::LDS_TBL);
  for (int i = tid_; i < 3 * NH * att::TBL_N; i += NT) { const int p = i / (NH * att::TBL_N), h = (i / att::TBL_N) % NH, x = i % att::TBL_N - att::TBL_O;
    tbl[i] = (x >= 0 && x <= 128) ? rel_bias[BUCKET[p][128 - x] * NH + h] * LOG2E : -INFINITY; }
}
__device__ __forceinline__ att::Task prompt_task(int pat, int b, int h, int r, int i0) {
  const int d = (pat == 0) ? 1 : (pat == 1) ? 4 : 16;
  att::Task T{}; T.row0 = b * SEQ + r + d * i0; T.rstep = d; T.head = h; T.pat = pat; T.nrows = 32; T.t0 = i0 >= 128 ? 0 : (128 - i0) >> 5;
  const size_t e0 = ((size_t)(b * NH + h) * SEQ + r + (size_t)d * i0) * HD;
  T.rs = 256 * d;
  T.Kb = WSP(bf16_t, W_KD) + e0 - (size_t)128 * d * HD; T.Vb = WSP(bf16_t, W_VD) + e0 - (size_t)128 * d * HD;
  return T;
}
__device__ __forceinline__ att::Task sample_task(int li, int b, int h, int t, int pbeg, int pend) {
  att::Task T{}; const size_t cb = ((size_t)(li * DB + b) * WIN) * 1024 + h * HD;
  T.row0 = MP + b * DS + t; T.rstep = 0; T.head = h; T.Kc = KIN(I_CK) + cb; T.Vc = KIN(I_CV) + cb; T.Kn = KOUT() + O_AKS + cb; T.Vn = KOUT() + O_AVS + cb;
  T.q0 = WIN + t; T.nrows = 1; T.pat = pbeg; T.pend = pend;
  return T;
}
__device__ __forceinline__ void cross_tasks(int li, char* lds, int wave, int lane, int t_lo, int t_hi, int slot, int nslots) {
  constexpr int NTASK_P = (MP / 32) * NXH;
  for (int tk = t_lo + slot; tk < t_hi; tk += nslots) {
    att::Task T{}; T.rstep = 1; T.t0 = 0; T.pat = 0; T.q0 = 128;
    if (tk < NTASK_P) {
      const int h = tk & 3, rt = tk >> 2, b = rt >> 7; const size_t kvo = ((size_t)li * 512 + b * NMEM) * 512 + h * HD;
      T.row0 = rt * 32; T.head = h; T.Kb = WSP(bf16_t, W_MKB) + kvo; T.Vb = WSP(bf16_t, W_MVB) + kvo; T.nrows = 32;
      att::wave_task<false, true, 0>(lds, wave, lane, T);
    } else {
      const int h = (tk - NTASK_P) & 3, b = (tk - NTASK_P) >> 2; const size_t kvo = ((size_t)(li * DB + b) * NMEM) * 512 + h * HD;
      T.row0 = MP + b * DS; T.head = h; T.Kb = WSP(bf16_t, W_CMKB) + kvo; T.Vb = WSP(bf16_t, W_CMVB) + kvo; T.nrows = DS;
      att::wave_task<false, true, 0>(lds, wave, lane, T);
    }
  }
}
__device__ __forceinline__ void ph_attn1(int li, char* lds, int wave_s) {
  OPAQUE_IDS
  const int lane = tid_ & 63, wave = wave_s;
  { const int x = bid_ & 7, j = (bid_ >> 3) * 8 + wave;
    for (int jj = j; jj < 256; jj += (nb_ >> 3) * 8) { const int bh = 2 * x + (jj >> 7), qt = jj & 127;
      { att::Task T = prompt_task(0, bh >> 3, bh & 7, 0, qt * 32); att::wave_task<false, false, 1>(lds, wave, lane, T); }
      { att::Task T = prompt_task(1, bh >> 3, bh & 7, qt >> 5, (qt & 31) * 32); att::wave_task<false, false, 1>(lds, wave, lane, T); } } }
  if (wave < 4) { for (int tk = bid_ * 4 + wave; tk < 2 * DB * NH * DS; tk += nb_ * 4) { const int pat = tk & 1, q = tk >> 1;
      att::Task T = sample_task(li, q >> 6, (q >> 3) & 7, q & 7, pat, pat + 1); att::wave_task<true, false, 1>(lds, wave, lane, T); } }
  else cross_tasks(li, lds, wave, lane, 0, (MP / 32) * NXH, bid_ * 4 + (wave - 4), nb_ * 4);
}
__device__ __forceinline__ void ph_attn2(int li, char* lds, int wave_s) {
  OPAQUE_IDS
  const int lane = tid_ & 63, wave = wave_s;
  const int x = bid_ & 7, j = (bid_ >> 3) * 8 + wave;
  for (int jj = j; jj < 256; jj += (nb_ >> 3) * 8) { const int bh = 2 * x + (jj >> 7), r16 = (jj >> 3) & 15, it = jj & 7;
    att::Task T = prompt_task(2, bh >> 3, bh & 7, r16, it * 32);
    att::wave_task<false, false, 2>(lds, wave, lane, T); }
  { const int vb_ = (bid_ + nb_ - 66 % nb_) % nb_;
    for (int q = vb_ * 8 + wave; q < DB * NH * DS; q += nb_ * 8) { att::Task T = sample_task(li, q >> 6, (q >> 3) & 7, q & 7, 2, 3); att::wave_task<true, false, 2>(lds, wave, lane, T); } }
  { const int vb2 = (bid_ + nb_ - 130 % nb_) % nb_;
    if (wave == 0) cross_tasks(li, lds, wave, lane, (MP / 32) * NXH, (MP / 32) * NXH + DB * NXH, vb2, nb_); }
}
__device__ __forceinline__ void ph_conv_tiles(int li, char* lds, int wave_s) {
  OPAQUE_IDS
  const int c = tid_, lane = tid_ & 63, wave = tid_ >> 6;
  const float* u = WSP(float, W_U); const float* state = KIN(I_ST) + (size_t)li * DB * 30 * CCH; const float* wdw = KIN(I_WDW) + (size_t)li * CK * CCH;
  const float* lg = KIN(I_LNG) + li * CCH; const float* lb = KIN(I_LNB) + li * CCH; bf16_t* cact = WSP(bf16_t, W_CACT);
  float* tile = (float*)lds;
  for (int tl = bid_; tl < MP / 32 + DB; tl += nb_) {
    const bool samp = tl >= MP / 32;
    const int ntok = samp ? DS : 32;
    float win[62];
    if (!samp) { const int t0 = (tl * 32) & (SEQ - 1); const float* ub = u + (size_t)(tl * 32 - 30) * CCH + c;
#pragma unroll
      for (int k = 0; k < 62; ++k) win[k] = (t0 - 30 + k >= 0) ? ub[(size_t)k * CCH] : 0.f; }
    else { const int b = tl - MP / 32; const float* sb = state + (size_t)b * 30 * CCH + c; const float* ub = u + (size_t)(MP + b * DS) * CCH + c;
#pragma unroll
      for (int k = 0; k < 62; ++k) win[k] = (k < 30) ? sb[(size_t)k * CCH] : (k < 30 + DS ? ub[(size_t)(k - 30) * CCH] : 0.f); }
    float w[CK];
#pragma unroll
    for (int k = 0; k < CK; ++k) w[k] = wdw[k * CCH + c];
    const float bias = KIN(I_BDW)[li * CCH + c];
    __syncthreads();
#pragma unroll
    for (int t = 0; t < 32; ++t) { if (t < ntok) { float a = bias;
#pragma unroll
      for (int k = 0; k < CK; ++k) a += w[k] * win[t + k];
      tile[t * CCH + c] = a; } }
    __syncthreads();
#pragma unroll
    for (int j = 0; j < 4; ++j) { const int t = wave * 4 + j;
      if (t < ntok) {
        const f4 v0 = *(const f4*)(tile + t * CCH + lane * 8), v1 = *(const f4*)(tile + t * CCH + lane * 8 + 4);
        const float mean = wave_sum((v0[0] + v0[1]) + (v0[2] + v0[3]) + (v1[0] + v1[1]) + (v1[2] + v1[3])) * (1.f / CCH);
        const f4 d0 = v0 - mean, d1 = v1 - mean;
        const float rstd = rsqrtf(wave_sum((d0[0] * d0[0] + d0[1] * d0[1]) + (d0[2] * d0[2] + d0[3] * d0[3]) + (d1[0] * d1[0] + d1[1] * d1[1]) + (d1[2] * d1[2] + d1[3] * d1[3])) * (1.f / CCH) + EPS);
        const f4 g0 = *(const f4*)(lg + lane * 8), g1 = *(const f4*)(lg + lane * 8 + 4), b0 = *(const f4*)(lb + lane * 8), b1 = *(const f4*)(lb + lane * 8 + 4);
        const f4 y0 = d0 * rstd * g0 + b0, y1 = d1 * rstd * g1 + b1;
        v4u o; o.x = pk2(silu(y0[0]), silu(y0[1])); o.y = pk2(silu(y0[2]), silu(y0[3])); o.z = pk2(silu(y1[0]), silu(y1[1])); o.w = pk2(silu(y1[2]), silu(y1[3]));
        const size_t row = samp ? (size_t)MP + (tl - MP / 32) * DS + t : (size_t)tl * 32 + t;
        *(v4u*)(cact + row * CCH + lane * 8) = o; } }
  }
  __syncthreads();
}

__device__ __forceinline__ void ph_postpre(int li, int wave_s) {
  OPAQUE_IDS
  const int lane = tid_ & 63;
  const bf16_t* y = WSP(bf16_t, W_Y); const float* ysq = WSP(float, W_YSQ);
  bf16_t* xcur = WSP(bf16_t, W_XCUR); bf16_t* xa = WSP(bf16_t, W_XA); float* out = KOUT(); const float* xp = KIN(I_XP); const float* xs = KIN(I_XS);
  f4 gv[8];
  { const f4* g = (const f4*)(KIN(I_GPOST) + li * DM);
#pragma unroll
    for (int p = 0; p < 4; ++p) { gv[2 * p] = g[128 * p + 2 * lane]; gv[2 * p + 1] = g[128 * p + 2 * lane + 1]; } }
#define PP_LOAD(ROW_, XB, Y, Q) do { const v4u* yr_ = (const v4u*)(y + (size_t)(ROW_) * DM); const v4u* xr_ = (const v4u*)(xcur + (size_t)(ROW_) * DM); Q = ysq[(size_t)(ROW_) * 32 + (lane & 31)]; \
    _Pragma("unroll") for (int p = 0; p < 4; ++p) { XB[p] = xr_[64 * p + lane]; Y[p] = yr_[64 * p + lane]; } } while (0)
#define UNLO(W) ((f4){bflo((W).x), bfhi((W).x), bflo((W).y), bfhi((W).y)})
#define UNHI(W) ((f4){bflo((W).z), bfhi((W).z), bflo((W).w), bfhi((W).w)})
#define PP_PROC(ROW_, XB, Y, Q) do { \
    const float rstd_y = rsqrtf(wave_sum(Q) * 0.5f / DM + EPS); f4 v[8]; float s = 0.f; \
    _Pragma("unroll") for (int p = 0; p < 4; ++p) { const f4 x0 = UNLO(XB[p]), x1 = UNHI(XB[p]); \
      v[2 * p] = x0 + UNLO(Y[p]) * rstd_y * gv[2 * p]; v[2 * p + 1] = x1 + UNHI(Y[p]) * rstd_y * gv[2 * p + 1]; } \
    _Pragma("unroll") for (int j = 0; j < 8; ++j) s += (v[j][0] * v[j][0] + v[j][1] * v[j][1]) + (v[j][2] * v[j][2] + v[j][3] * v[j][3]); \
    if (li == DEPTH - 1) { f4* xo = (f4*)(((ROW_) < MP) ? out + O_YP + (size_t)(ROW_) * DM : out + O_YS + (size_t)((ROW_) - MP) * DM); \
      _Pragma("unroll") for (int p = 0; p < 4; ++p) { xo[128 * p + 2 * lane] = v[2 * p]; xo[128 * p + 2 * lane + 1] = v[2 * p + 1]; } \
    } else { const float rstd = rsqrtf(wave_sum(s) / DM + EPS); v4u* o = (v4u*)(xa + (size_t)(ROW_) * DM); v4u* xo = (v4u*)(xcur + (size_t)(ROW_) * DM); \
      _Pragma("unroll") for (int p = 0; p < 4; ++p) { const f4 a = v[2 * p], c = v[2 * p + 1]; v4u wx, wa; \
        wx.x = pk2(a[0], a[1]); wx.y = pk2(a[2], a[3]); wx.z = pk2(c[0], c[1]); wx.w = pk2(c[2], c[3]); \
        wa.x = pk2(a[0] * rstd, a[1] * rstd); wa.y = pk2(a[2] * rstd, a[3] * rstd); wa.z = pk2(c[0] * rstd, c[1] * rstd); wa.w = pk2(c[2] * rstd, c[3] * rstd); \
        xo[64 * p + lane] = wx; o[64 * p + lane] = wa; } } } while (0)
  int w = GW; if (w >= MT) return;
  v4u xbA[4], yvA[4], xbB[4], yvB[4]; float qA, qB = 0.f;
  PP_LOAD(w, xbA, yvA, qA);
  if (w + NGW < MT) PP_LOAD(w + NGW, xbB, yvB, qB);
  for (;;) {
    PP_PROC(w, xbA, yvA, qA);
    if (w + 2 * NGW < MT) PP_LOAD(w + 2 * NGW, xbA, yvA, qA);
    if (w + NGW >= MT) break;
    PP_PROC(w + NGW, xbB, yvB, qB);
    if (w + 3 * NGW < MT) PP_LOAD(w + 3 * NGW, xbB, yvB, qB);
    w += 2 * NGW; if (w >= MT) break;
  }
#undef PP_PROC
#undef PP_LOAD
#undef UNLO
#undef UNHI
}

#define XB_TMO      128
#define XB_XCNT(j)  (256  + 64 * (j))
#define XB_XSUB(j)  (1280 + 64 * (j))
#define XB_XGEN(j)  (2304 + 64 * (j))
#define XB_TOP      3328
#define XB_TOPGEN   3392
#define XCD_BAR_WORDS 3456
#define XB_SPIN_CAP (1u << 20)
__device__ __forceinline__ unsigned xb_ld(unsigned* p)              { return __hip_atomic_load(p, __ATOMIC_RELAXED, __HIP_MEMORY_SCOPE_AGENT); }
__device__ __forceinline__ unsigned xb_add(unsigned* p, unsigned v) { return __hip_atomic_fetch_add(p, v, __ATOMIC_RELAXED, __HIP_MEMORY_SCOPE_AGENT); }
__device__ __forceinline__ unsigned xb_xcc_id() { return (unsigned)__builtin_amdgcn_s_getreg((3 << 11) | 20) & 0xFu; }
#define XB_SPIN(cond, bar) do { unsigned _sp = 0; while (cond) { __builtin_amdgcn_s_sleep(1); \
    if ((++_sp & 255u) == 0u) { if (xb_ld(&(bar)[XB_TMO])) break; if (_sp > XB_SPIN_CAP) { atomicAdd(&(bar)[XB_TMO], 1u); break; } } } } while (0)
__device__ __forceinline__ void xcd_barrier_post(unsigned* bar, int wave_s) { if (wave_s == 0 && lane_id_v() == 0) (void)xb_add(&bar[XB_XCNT(xb_xcc_id())], 1u); }
__device__ __forceinline__ void xcd_barrier_complete(unsigned* bar, unsigned x, unsigned G, unsigned& nloc, unsigned& nx) {
    unsigned sum, cnt, mine, sp = 0u;
    for (;;) {
        sum = 0u; cnt = 0u; mine = 0u;
#pragma unroll
        for (unsigned j = 0; j < 16; ++j) { const unsigned c = xb_ld(&bar[XB_XCNT(j)]); sum += c; cnt += (c > 0u) ? 1u : 0u; mine = (j == x) ? c : mine; }
        if (sum == G) break;
        __builtin_amdgcn_s_sleep(1);
        if ((++sp & 255u) == 0u) { if (xb_ld(&bar[XB_TMO])) break; if (sp > XB_SPIN_CAP) { atomicAdd(&bar[XB_TMO], 1u); break; } }
    }
    nloc = mine > 0u ? mine : 1u; nx = cnt > 0u ? cnt : 1u;
}
__device__ __forceinline__ void xcd_barrier(unsigned* bar, volatile LAS unsigned* st, int wave_s) {
    asm volatile("s_waitcnt vmcnt(0)" ::: "memory");
    __syncthreads();
    if (wave_s == 0 && lane_id_v() == 0) {
        __builtin_amdgcn_s_waitcnt(0);
        const unsigned x = xb_xcc_id();
        unsigned nloc = st[0], nx = st[1];
        if (nloc == 0u) { xcd_barrier_complete(bar, x, gridDim.x, nloc, nx); st[0] = nloc; st[1] = nx; }
        const unsigned old = xb_add(&bar[XB_XSUB(x)], 1u);
        const unsigned gen = old / nloc;
        if (old + 1u == (gen + 1u) * nloc) {
            __builtin_amdgcn_fence(__ATOMIC_RELEASE, "agent");
            asm volatile("s_waitcnt vmcnt(0)" ::: "memory");
            const unsigned og = xb_add(&bar[XB_TOP], 1u);
            const unsigned tg = og / nx;
            if (og + 1u == (tg + 1u) * nx) xb_add(&bar[XB_TOPGEN], 1u);
            else XB_SPIN(xb_ld(&bar[XB_TOPGEN]) == tg, bar);
            __builtin_amdgcn_fence(__ATOMIC_ACQUIRE, "agent");
            xb_add(&bar[XB_XGEN(x)], 1u);
            asm volatile("s_waitcnt vmcnt(0)" ::: "memory");
        } else {
            XB_SPIN(xb_ld(&bar[XB_XGEN(x)]) == gen, bar);
            __builtin_amdgcn_fence(__ATOMIC_ACQUIRE, "agent");
            asm volatile("s_waitcnt vmcnt(0)" ::: "memory");
        }
    }
    __syncthreads();
}

__global__ void __launch_bounds__(NT, 2) fwd_mega(Params p) {
  extern __shared__ __attribute__((aligned(16))) unsigned char lds[];
  cg::grid_group grid = cg::this_grid();
  PG8_LAS unsigned char* lds3 = (PG8_LAS unsigned char*)lds;
  const int wave_s = __builtin_amdgcn_readfirstlane(threadIdx.x >> 6);
  volatile LAS unsigned* bst = (volatile LAS unsigned*)((LAS unsigned char*)lds + LDS_MISC);
  if (threadIdx.x < 2) bst[threadIdx.x] = 0u;
  build_bias_tables((char*)lds, wave_s);
  ph_prologue((float*)lds, wave_s);
  if (KWS() == nullptr) grid.sync();
  xcd_barrier_post(WSP(unsigned, W_BAR), wave_s);
  xcd_barrier(WSP(unsigned, W_BAR), bst, wave_s);
#ifndef PROBE_SUB
#define PROBE_SUB -99
#endif
#pragma unroll 1
  for (int ph = 0; ph < DEPTH * 5; ++ph) {
    const int li = ph / 5, sub = ph % 5 + 1;
#pragma unroll 1
    for (int rep = 0; rep < ((sub == PROBE_SUB && (sub != 5 || li == 0 || li == DEPTH - 1)) ? 2 : 1); ++rep) {
    if (sub == 1 || sub == 3 || sub == 4) {
      pg8::Gemm g; pg8::EpiMulti E; int extra = 0;
      if (sub == 1) { g = pg8::Gemm{WSP(bf16_t, W_XA), WIN_L(li), MPAD, INW, DM}; E = pg8::EpiMulti{1, li}; extra = (li == 0) ? 32 : 0; }
      else if (sub == 3) { g = pg8::Gemm{WSP(bf16_t, W_CACT), WSP(bf16_t, W_WPW) + (size_t)li * CCH * CCH, MPAD, CCH, CCH}; E = pg8::EpiMulti{3, li}; }
      else { g = pg8::Gemm{WSP(bf16_t, W_MIX), WSP(bf16_t, W_WOUT) + (size_t)li * DM * MIXW, MPAD, DM, MIXW}; E = pg8::EpiMulti{2, li}; }
      int bid_ = blockIdx.x; asm volatile("" : "+s"(bid_)); int nb_ = gridDim.x; asm volatile("" : "+s"(nb_));
      pg8::StaticOrder S; S.init(g.M, g.N, nb_, bid_, extra);
      pg8::gemm_phase<pg8::EpiMulti, pg8::StaticOrder, true, true>(lds3, g, S, E, wave_s);
      if (sub == 1 || sub == 4) {
        const int nwgA = (MPAD / 256) * (INW / 256) + ((li == 0) ? 32 : 0), nwgC = (MPAD / 256) * (DM / 256);
        const int firstA = nwgA - (nwgA - 1) / nb_ * nb_, firstC = nwgC - (nwgC - 1) / nb_ * nb_;
        const int nslot = ((nb_ - firstA) + (nb_ - firstC)) * 8;
        const int first = (sub == 1) ? firstA : firstC;
        if (bid_ >= first) ph_filler(li, ((sub == 1) ? 0 : (nb_ - firstA) * 8) + (bid_ - first) * 8 + wave_s, 1, nslot, (float*)lds, wave_s);
      }
    }
    if (sub == 2) { ph_conv_tiles(li, (char*)lds, wave_s); ph_attn1(li, (char*)lds, wave_s); }
    else if (sub == 3) ph_attn2(li, (char*)lds, wave_s);
    else if (sub == 5) ph_postpre(li, wave_s);
    if (ph < DEPTH * 5 - 1) xcd_barrier(WSP(unsigned, W_BAR), bst, wave_s);
    }
  }
}

extern "C" void kernel_launch(void* const* d_in, const int* in_sizes, int n_in, void* d_out, int out_size, void* d_ws, size_t ws_size, hipStream_t stream) {
  static int grid_blocks = 0;
  if (!grid_blocks) {
    int dev = 0, cus = 0, per_cu = 0;
    (void)hipGetDevice(&dev);
    (void)hipDeviceGetAttribute(&cus, hipDeviceAttributeMultiprocessorCount, dev);
    (void)hipFuncSetAttribute((const void*)fwd_mega, hipFuncAttributeMaxDynamicSharedMemorySize, LDS_BYTES);
    (void)hipOccupancyMaxActiveBlocksPerMultiprocessor(&per_cu, (const void*)fwd_mega, NT, LDS_BYTES);
    if (per_cu < 1) { fprintf(stderr, "occupancy query returned %d\n", per_cu); per_cu = 1; }
    grid_blocks = cus * per_cu;
    if (ws_size < W_END) fprintf(stderr, "workspace too small: %zu < %zu\n", ws_size, (size_t)W_END);
  }
  (void)hipMemsetAsync((unsigned char*)d_ws + W_BAR, 0, 16384, stream);
  Params p{};
  for (int i = 0; i < 19; ++i) p.in[i] = (const float*)d_in[i];
  p.out = (float*)d_out; p.ws = (unsigned char*)d_ws;
  void* args[] = {&p};
  hipError_t e = hipLaunchCooperativeKernel((const void*)fwd_mega, dim3(grid_blocks), dim3(NT), args, LDS_BYTES, stream);
  if (e != hipSuccess) fprintf(stderr, "cooperative launch failed: %s (grid %d)\n", hipGetErrorString(e), grid_blocks);
}
```

```cpp
#include <hip/hip_runtime.h>
#include <hip/hip_cooperative_groups.h>
#include <cstdio>
#include <cstdint>
namespace cg = cooperative_groups;

constexpr int DM = 2048, BATCH = 2, SEQ = 4096, DEPTH = 4, DB = 8, DS = 8;
constexpr int NMEM = 256, HD = 128, ATT_W = 1024, NH = 8, WIN = 2048;
constexpr int CCH = 512, CK = 31, XW = 512, NXH = 4, MIXW = 2048, INW = 6656;
constexpr int MP = BATCH * SEQ;
constexpr int MS = DB * DS;
constexpr int MT = MP + MS;
constexpr int MPAD = 8448;
constexpr float EPS = 1e-6f;
constexpr float SCALE = 0.08838834764831845f, LOG2E = 1.4426950408889634f, QS = SCALE * LOG2E;
constexpr int NT = 512;
constexpr int LDS_BYTES = 155648;

__device__ const unsigned char BUCKET[3][129] = {
 {0,1,2,3,4,5,6,7,8,9,10,11,12,13,14,15,16,16,16,16,16,16,17,17,17,17,17,17,17,17,18,18,18,18,18,18,18,18,18,18,19,19,19,19,19,19,19,19,19,19,19,19,19,19,20,20,20,20,20,20,20,20,20,20,20,20,20,20,20,20,20,20,20,21,21,21,21,21,21,21,21,21,21,21,21,21,21,21,21,21,21,21,21,21,21,21,21,21,21,22,22,22,22,22,22,22,22,22,22,22,22,22,22,22,22,22,22,22,22,22,22,22,22,22,22,22,22,22,22},
 {0,4,8,12,16,16,17,17,18,18,19,19,19,19,20,20,20,20,20,21,21,21,21,21,21,22,22,22,22,22,22,22,22,22,23,23,23,23,23,23,23,23,23,23,23,23,24,24,24,24,24,24,24,24,24,24,24,24,24,24,24,24,25,25,25,25,25,25,25,25,25,25,25,25,25,25,25,25,25,25,25,25,25,26,26,26,26,26,26,26,26,26,26,26,26,26,26,26,26,26,26,26,26,26,26,26,26,26,26,26,26,26,26,27,27,27,27,27,27,27,27,27,27,27,27,27,27,27,27},
 {0,16,18,19,20,21,21,22,22,23,23,23,24,24,24,24,25,25,25,25,25,26,26,26,26,26,26,26,26,27,27,27,27,27,27,27,27,27,27,28,28,28,28,28,28,28,28,28,28,28,28,28,29,29,29,29,29,29,29,29,29,29,29,29,29,29,29,29,29,29,30,30,30,30,30,30,30,30,30,30,30,30,30,30,30,30,30,30,30,30,30,30,30,30,30,31,31,31,31,31,31,31,31,31,31,31,31,31,31,31,31,31,31,31,31,31,31,31,31,31,31,31,31,31,31,31,31,31,31}};

typedef unsigned short bf16_t;
typedef unsigned v4u __attribute__((ext_vector_type(4)));
typedef float f4 __attribute__((ext_vector_type(4)));
__device__ __forceinline__ unsigned f2bf(float f) { unsigned u = __builtin_bit_cast(unsigned, f); return (u + 0x7fffu + ((u >> 16) & 1u)) >> 16; }
__device__ __forceinline__ unsigned pk2(float lo, float hi) { unsigned r; asm("v_cvt_pk_bf16_f32 %0, %1, %2" : "=v"(r) : "v"(lo), "v"(hi)); return r; }
__device__ __forceinline__ float bf2f(unsigned short b) { return __builtin_bit_cast(float, (unsigned)b << 16); }
__device__ __forceinline__ float bflo(unsigned w) { return __builtin_bit_cast(float, w << 16); }
__device__ __forceinline__ float bfhi(unsigned w) { return __builtin_bit_cast(float, w & 0xffff0000u); }
__device__ __forceinline__ float wave_sum(float v) {
#pragma unroll
  for (int o = 1; o < 64; o <<= 1) v += __shfl_xor(v, o);
  return v;
}
__device__ __forceinline__ float sigmoidf(float x) { return __builtin_amdgcn_rcpf(1.f + __builtin_amdgcn_exp2f(-LOG2E * x)); }
__device__ __forceinline__ float silu(float x) { return x * sigmoidf(x); }

struct Params { const float* in[19]; float* out; unsigned char* ws; };
__device__ __forceinline__ unsigned long long karg(int k) {
  const volatile unsigned long long __attribute__((address_space(4)))* ka = (const volatile unsigned long long __attribute__((address_space(4)))*)__builtin_amdgcn_kernarg_segment_ptr();
  return ka[k];
}
#define GAS __attribute__((address_space(1)))
#define KIN(k) ((const float*)(const GAS float*)karg(k))
#define KOUT() ((float*)(GAS float*)karg(19))
#define KWS() ((unsigned char*)(GAS unsigned char*)karg(20))
enum { I_XP = 0, I_XS, I_MEM, I_CK, I_CV, I_ST, I_CMK, I_CMV, I_RB, I_GPRE, I_WIN, I_WDW, I_BDW, I_LNG, I_LNB, I_WPW, I_WMKV, I_WOUT, I_GPOST };
constexpr size_t O_YP = 0, O_YS = O_YP + (size_t)MP * DM, O_AKP = O_YS + (size_t)MS * DM, O_AVP = O_AKP + (size_t)DEPTH * BATCH * WIN * 1024,
  O_CVP = O_AVP + (size_t)DEPTH * BATCH * WIN * 1024, O_MKP = O_CVP + (size_t)DEPTH * BATCH * 30 * CCH, O_MVP = O_MKP + (size_t)DEPTH * 512 * 512,
  O_AKS = O_MVP + (size_t)DEPTH * 512 * 512, O_AVS = O_AKS + (size_t)DEPTH * DB * WIN * 1024, O_CVS = O_AVS + (size_t)DEPTH * DB * WIN * 1024;
constexpr size_t al256(size_t x) { return (x + 255) / 256 * 256; }
constexpr size_t KD_BYTES = al256((size_t)BATCH * NH * SEQ * HD * 2), PO_BYTES = al256((size_t)MPAD * 1024 * 2), PM_BYTES = al256((size_t)MPAD * NH * 4);
constexpr size_t W_WIN = 0, W_WMKV = W_WIN + (size_t)DEPTH * INW * DM * 2, W_WOUT = W_WMKV + al256((size_t)DEPTH * 1024 * DM * 2), W_WPW = W_WOUT + al256((size_t)DEPTH * DM * MIXW * 2),
  W_XCUR = W_WPW + al256((size_t)DEPTH * CCH * CCH * 2), W_XA = W_XCUR + al256((size_t)MT * DM * 4), W_MEMB = W_XA + (size_t)MPAD * DM * 2,
  W_QB = W_MEMB + al256((size_t)512 * DM * 2),
 W_KD = W_QB + al256((size_t)MPAD * 1024 * 2), W_VD = W_KD + 3 * al256((size_t)BATCH * NH * SEQ * HD * 2), W_GAB = W_VD + 3 * al256((size_t)BATCH * NH * SEQ * HD * 2),
  W_U = W_GAB + al256((size_t)MPAD * 1024 * 2), W_GCB = W_U + al256((size_t)MPAD * CCH * 4), W_QMB = W_GCB + al256((size_t)MPAD * 512 * 2), W_GMB = W_QMB + al256((size_t)MPAD * 512 * 2),
  W_MKB = W_GMB + al256((size_t)MPAD * 512 * 2), W_MVB = W_MKB + al256((size_t)DEPTH * 512 * 512 * 2), W_CACT = W_MVB + al256((size_t)DEPTH * 512 * 512 * 2),
  W_MIX = W_CACT + al256((size_t)MPAD * CCH * 2), W_Y = W_MIX + al256((size_t)MPAD * MIXW * 2), W_YSQ = W_Y + al256((size_t)MPAD * DM * 2),     W_PO = W_YSQ + al256((size_t)MPAD * 32 * 4), W_PM = W_PO + 2 * PO_BYTES, W_PL = W_PM + 2 * PM_BYTES,
  W_BAR = W_PL + 2 * PM_BYTES, W_CMKB = W_BAR + 16384, W_CMVB = W_CMKB + al256((size_t)DEPTH * DB * NMEM * 512 * 2), W_END = W_CMVB + al256((size_t)DEPTH * DB * NMEM * 512 * 2);
#define WSP(type, off) ((type*)(KWS() + (off)))
#define WIN_L(li) (WSP(bf16_t, W_WIN) + (size_t)(((li) + DEPTH - 1) % DEPTH) * INW * DM)
#define LAS __attribute__((address_space(3)))
constexpr int LDS_MISC = 153600;
__device__ __forceinline__ int lane_id_v() { int l; asm volatile("v_mbcnt_lo_u32_b32 %0, -1, 0\n\tv_mbcnt_hi_u32_b32 %0, -1, %0" : "=v"(l)); return l; }
#define LANE_ID() lane_id_v()
#define OPAQUE_IDS int ws_ = wave_s; asm volatile("" : "+s"(ws_)); int tid_ = ws_ * 64 + LANE_ID(); asm volatile("" : "+v"(tid_)); int bid_ = blockIdx.x; asm volatile("" : "+s"(bid_)); int nb_ = gridDim.x; asm volatile("" : "+s"(nb_));
#define GW   ((int)((bid_ * NT + tid_) >> 6))
#define NGW  ((int)(nb_ * (NT / 64)))
#define GT   ((size_t)bid_ * NT + tid_)
#define NGT  ((size_t)nb_ * NT)

namespace pg8 {
#define PG8_LAS __attribute__((address_space(3)))
typedef unsigned short bf16_t;
typedef short bf16x8 __attribute__((ext_vector_type(8)));
typedef float f32x4 __attribute__((ext_vector_type(4)));
typedef unsigned u32x4 __attribute__((ext_vector_type(4)));
constexpr int BM = 256, BK = 64, HALF = 128, HTB = HALF * BK * 2  , STAGE_BYTES = 8 * HTB, NXCD = 8, WGM = 8;

__host__ __device__ __forceinline__ int lds_byte(int r, int c) { const int st = (r >> 4) * 2 + (c >> 5), rr = r & 15, cc = c & 31, ob = rr * 64 + cc * 2; return st * 1024 + (ob ^ (((ob >> 9) & 1) << 5)); }
__host__ __device__ __forceinline__ void stage_rc(int b, int& R, int& C) { const int st = b / 1024, sb = b % 1024, swz = sb ^ (((sb >> 9) & 1) << 5); R = (st >> 1) * 16 + swz / 64; C = (st & 1) * 32 + (swz % 64) / 2; }
__host__ __device__ __forceinline__ int perm32(int rho) { const int n = rho >> 4, i = rho & 15; return 8 * (i >> 2) + 4 * n + (i & 3); }

struct Unit { int pm, pn; };
struct Gemm { const bf16_t* A; const bf16_t* Bt; int M, N, K; };

struct StaticOrder {
    int nM, nN, nwg, G, c, extra;
    __host__ __device__ void init(int M, int N, int G_, int c_, int extra_ = 0) { nM = M / BM; nN = N / BM; nwg = nM * nN; G = G_; c = c_; extra = extra_; }
    __host__ __device__ bool next(int i, Unit& u) const {
        const long L = (long)i * G + c; if (L >= nwg) { const int e = (int)(L - nwg); if (e >= extra) return false; u.pm = nM + (e & 1); u.pn = nN + (e >> 1); return true; }
        int wgid = (int)L; { const int q = nwg / NXCD, r = nwg % NXCD, xcd = wgid % NXCD, off = wgid / NXCD; wgid = (xcd < r ? xcd * (q + 1) : r * (q + 1) + (xcd - r) * q) + off; }
        const int nig = WGM * nN, gid = wgid / nig, fm = gid * WGM, gsz = (nM - fm) < WGM ? (nM - fm) : WGM;
        u.pm = fm + ((wgid % nig) % gsz); u.pn = (wgid % nig) / gsz; return true;
    }
    __device__ __forceinline__ void a_ready(const Unit&) const {}
    __device__ __forceinline__ void done(const Unit&) const {}
};

__device__ __forceinline__ unsigned cvt_pk_bf16(float lo, float hi) { unsigned r; asm volatile("v_cvt_pk_bf16_f32 %0, %1, %2" : "=v"(r) : "v"(lo), "v"(hi)); return r; }
typedef float f32x2 __attribute__((ext_vector_type(2)));
template <class Epi, class Sched, bool ALIGN_EPI = false, bool SP2 = false>
__device__ __forceinline__ void gemm_phase(PG8_LAS unsigned char* lds, const Gemm g, const Sched& S, const Epi& E, int wave_s) {
    int ws_ = wave_s; asm volatile("" : "+s"(ws_)); int tid_ = ws_ * 64 + lane_id_v(); asm volatile("" : "+v"(tid_));
    const int tid = tid_, wid = __builtin_amdgcn_readfirstlane(tid >> 6), lane = tid & 63, wr = wid >> 2, wc = wid & 3, fr = lane & 15, fq = lane >> 4;
    const int K = g.K, nt = K / BK;
    unsigned voffA[2], voffB[2];
#pragma unroll
    for (int i = 0; i < 2; ++i) { int R, C; stage_rc(tid * 16 + i * 8192, R, C); const int Rb = Epi::PERM ? ((R & ~31) + perm32(R & 31)) : R;
        voffA[i] = (unsigned)(R * K + C) * 2u; voffB[i] = (unsigned)(Rb * K + C) * 2u; }
    const size_t kstep = (size_t)(BK * 2);
    const size_t hstep = (size_t)HALF * K * 2;
    const size_t tstep = 2 * hstep;
    const unsigned ldsw = (unsigned)wid * 1024u;
    const int aoff = lds_byte(wr * 64 + fr, fq * 8), boff = lds_byte(wc * 32 + fr, fq * 8);
#define PG8_SA(b, h) (((b) * 2 + (h)) * HTB)
#define PG8_SB(b, h) ((4 + (b) * 2 + (h)) * HTB)
#define PG8_STAGE(bufoff, gbase, voff) do { _Pragma("unroll") for (int _i = 0; _i < 2; ++_i) \
        __builtin_amdgcn_global_load_lds((const unsigned*)((const char*)(gbase) + (voff)[_i]), (PG8_LAS unsigned*)(lds + (bufoff) + ldsw + _i * 8192), 16, 0, 0); } while (0)
#define PG8_LDA(dst, b, h) do { _Pragma("unroll") for (int m = 0; m < 4; ++m) _Pragma("unroll") for (int k = 0; k < 2; ++k) dst[m][k] = *(const PG8_LAS bf16x8*)(lds + PG8_SA(b, h) + aoff + m * 2048 + k * 1024); } while (0)
#define PG8_LDB(dst, b, h) do { _Pragma("unroll") for (int n = 0; n < 2; ++n) _Pragma("unroll") for (int k = 0; k < 2; ++k) dst[n][k] = *(const PG8_LAS bf16x8*)(lds + PG8_SB(b, h) + boff + n * 2048 + k * 1024); } while (0)
#define PG8_MMA(ai, bj, At, Bt) do { __builtin_amdgcn_s_setprio(1); _Pragma("unroll") for (int m = 0; m < 4; ++m) _Pragma("unroll") for (int n = 0; n < 2; ++n) _Pragma("unroll") for (int k = 0; k < 2; ++k) \
        acc[ai][bj][m][n] = __builtin_amdgcn_mfma_f32_16x16x32_bf16(Bt[n][k], At[m][k], acc[ai][bj][m][n], 0, 0, 0); __builtin_amdgcn_s_setprio(0); } while (0)
#define PG8_WAIT_V(n) asm volatile("s_waitcnt vmcnt(" #n ")" ::: "memory")
#define PG8_WAIT_L(n) asm volatile("s_waitcnt lgkmcnt(" #n ")" ::: "memory")
#define PG8_BAR __builtin_amdgcn_s_barrier()
#define PG8_SCHED __builtin_amdgcn_sched_barrier(0)
    Unit cur, nxt; int ui = 0;
    if (!S.next(0, cur)) return;
    f32x4 acc[2][2][4][2];
#pragma unroll
    for (int a = 0; a < 2; ++a)
#pragma unroll
        for (int b = 0; b < 2; ++b)
#pragma unroll
            for (int m = 0; m < 4; ++m)
#pragma unroll
                for (int n = 0; n < 2; ++n) acc[a][b][m][n] = (f32x4){0.f, 0.f, 0.f, 0.f};
    bf16x8 At[4][2], B0[2][2], B1[2][2];
    const char* cA = (const char*)g.A + (size_t)cur.pm * tstep; const char* cB = (const char*)g.Bt + (size_t)cur.pn * tstep;
    S.a_ready(cur);
    if constexpr (SP2) {
        PG8_STAGE(PG8_SB(0, 0), cB, voffB); PG8_STAGE(PG8_SB(0, 1), cB + hstep, voffB); PG8_STAGE(PG8_SA(0, 0), cA, voffA); PG8_STAGE(PG8_SA(0, 1), cA + hstep, voffA);
        if (wr == 1) PG8_BAR;
        PG8_WAIT_V(2); PG8_BAR;
        PG8_STAGE(PG8_SB(1, 0), cB + kstep, voffB); PG8_STAGE(PG8_SA(1, 0), cA + kstep, voffA); PG8_STAGE(PG8_SB(1, 1), cB + hstep + kstep, voffB);
        PG8_WAIT_V(6); PG8_BAR;
    } else {
        PG8_STAGE(PG8_SB(0, 0), cB, voffB); PG8_STAGE(PG8_SA(0, 0), cA, voffA); PG8_STAGE(PG8_SB(0, 1), cB + hstep, voffB); PG8_STAGE(PG8_SA(0, 1), cA + hstep, voffA);
        if (wr == 1) PG8_BAR;
        PG8_WAIT_V(4); PG8_BAR;
        PG8_STAGE(PG8_SB(1, 0), cB + kstep, voffB); PG8_STAGE(PG8_SA(1, 0), cA + kstep, voffA); PG8_STAGE(PG8_SB(1, 1), cB + hstep + kstep, voffB);
        PG8_WAIT_V(6); PG8_BAR;
    }
    for (;;) {
        const bool has_next = S.next(ui + 1, nxt);
        const char* nA = has_next ? (const char*)g.A + (size_t)nxt.pm * tstep : cA; const char* nB = has_next ? (const char*)g.Bt + (size_t)nxt.pn * tstep : cB;
        for (int t = 0; t < nt; t += 2) {
            const bool last = (t == nt - 2);
            const char* a1 = cA + (size_t)(t + 1) * kstep;
            const char* a2 = last ? nA : cA + (size_t)(t + 2) * kstep; const char* b2 = last ? nB : cB + (size_t)(t + 2) * kstep;
            const char* a3 = a2 + kstep; const char* b3 = b2 + kstep;
            if (last && has_next) S.a_ready(nxt);
            if constexpr (SP2) {
            PG8_LDB(B0, 0, 0); PG8_LDB(B1, 0, 1); PG8_SCHED; PG8_LDA(At, 0, 0); PG8_STAGE(PG8_SA(1, 1), a1 + hstep, voffA);
            PG8_WAIT_V(8); PG8_WAIT_L(0); PG8_BAR; PG8_MMA(0, 0, At, B0); PG8_MMA(0, 1, At, B1); PG8_BAR; PG8_SCHED;
            PG8_LDA(At, 0, 1); PG8_STAGE(PG8_SB(0, 0), b2, voffB); PG8_STAGE(PG8_SB(0, 1), b2 + hstep, voffB); PG8_STAGE(PG8_SA(0, 0), a2, voffA);
            PG8_WAIT_V(8); PG8_WAIT_L(0); PG8_BAR; PG8_MMA(1, 0, At, B0); PG8_MMA(1, 1, At, B1); PG8_BAR; PG8_SCHED;
            PG8_LDB(B0, 1, 0); PG8_LDB(B1, 1, 1); PG8_SCHED; PG8_LDA(At, 1, 0); PG8_STAGE(PG8_SA(0, 1), a2 + hstep, voffA);
            PG8_WAIT_V(8); PG8_WAIT_L(0); PG8_BAR; PG8_MMA(0, 0, At, B0); PG8_MMA(0, 1, At, B1); PG8_BAR; PG8_SCHED;
            PG8_LDA(At, 1, 1); PG8_STAGE(PG8_SB(1, 0), b3, voffB); PG8_STAGE(PG8_SB(1, 1), b3 + hstep, voffB); PG8_STAGE(PG8_SA(1, 0), a3, voffA);
            PG8_WAIT_V(8); PG8_WAIT_L(0); PG8_BAR; PG8_MMA(1, 0, At, B0); PG8_MMA(1, 1, At, B1); PG8_BAR; PG8_SCHED;
            } else {
            PG8_LDB(B0, 0, 0); PG8_SCHED; PG8_LDA(At, 0, 0); PG8_STAGE(PG8_SA(1, 1), a1 + hstep, voffA);
            PG8_WAIT_L(8); PG8_BAR; PG8_WAIT_L(0); PG8_MMA(0, 0, At, B0); PG8_BAR; PG8_SCHED;
            PG8_LDB(B1, 0, 1); PG8_STAGE(PG8_SB(0, 0), b2, voffB);
            PG8_BAR; PG8_WAIT_L(0); PG8_MMA(0, 1, At, B1); PG8_BAR;
            PG8_LDA(At, 0, 1); PG8_STAGE(PG8_SA(0, 0), a2, voffA);
            PG8_BAR; PG8_WAIT_L(0); PG8_MMA(1, 0, At, B0); PG8_BAR; PG8_SCHED;
            PG8_STAGE(PG8_SB(0, 1), b2 + hstep, voffB);
            PG8_WAIT_V(6); PG8_BAR; PG8_MMA(1, 1, At, B1); PG8_BAR;
            PG8_LDB(B0, 1, 0); PG8_SCHED; PG8_LDA(At, 1, 0); PG8_STAGE(PG8_SA(0, 1), a2 + hstep, voffA);
            PG8_WAIT_L(8); PG8_BAR; PG8_WAIT_L(0); PG8_MMA(0, 0, At, B0); PG8_BAR; PG8_SCHED;
            PG8_LDB(B1, 1, 1); PG8_STAGE(PG8_SB(1, 0), b3, voffB);
            PG8_BAR; PG8_WAIT_L(0); PG8_MMA(0, 1, At, B1); PG8_BAR;
            PG8_LDA(At, 1, 1); PG8_STAGE(PG8_SA(1, 0), a3, voffA);
            PG8_BAR; PG8_WAIT_L(0); PG8_MMA(1, 0, At, B0); PG8_BAR; PG8_SCHED;
            PG8_STAGE(PG8_SB(1, 1), b3 + hstep, voffB);
            PG8_WAIT_V(6); PG8_BAR; PG8_MMA(1, 1, At, B1); PG8_BAR;
            }
        }
        if constexpr (ALIGN_EPI) { if (wr == 0) PG8_BAR; }
        if constexpr (!Epi::AFTER_DRAIN) { E(acc, cur, wr, wc, fr, fq); S.done(cur); }
        if (!has_next) break;
#pragma unroll
        for (int a = 0; a < 2; ++a)
#pragma unroll
            for (int b = 0; b < 2; ++b)
#pragma unroll
                for (int m = 0; m < 4; ++m)
#pragma unroll
                    for (int n = 0; n < 2; ++n) acc[a][b][m][n] = (f32x4){0.f, 0.f, 0.f, 0.f};
        cur = nxt; cA = nA; cB = nB; ++ui;
        if constexpr (ALIGN_EPI) { if (wr == 1) PG8_BAR; }
    }
    PG8_WAIT_V(0);
    if constexpr (!ALIGN_EPI) { if (wr == 0) PG8_BAR; }
    PG8_BAR;
    if constexpr (Epi::AFTER_DRAIN) { E.fused(acc, cur, wr, wc, fr, fq, lds, wid, lane); S.done(cur); }
#undef PG8_SA
#undef PG8_SB
#undef PG8_STAGE
#undef PG8_LDA
#undef PG8_LDB
#undef PG8_MMA
#undef PG8_WAIT_V
#undef PG8_WAIT_L
#undef PG8_BAR
#undef PG8_SCHED
}
}

namespace pg8 {
struct EpiMulti {
    static constexpr bool PERM = true, AFTER_DRAIN = false;
    int mode, li;
    static __device__ __forceinline__ v4u pack8(f32x4 a, f32x4 b) { v4u w; w.x = cvt_pk_bf16(a[0], a[1]); w.y = cvt_pk_bf16(a[2], a[3]); w.z = cvt_pk_bf16(b[0], b[1]); w.w = cvt_pk_bf16(b[2], b[3]); return w; }
    __device__ __forceinline__ void operator()(const f32x4 (&acc)[2][2][4][2], const Unit& u, int wr, int wc, int fr, int fq) const {
        const int rt = u.pm * BM + wr * 64 + fr, ct = wc * 32 + 8 * fq;
        unsigned char* ws = KWS();
        if (mode == 1 && u.pm < MPAD / BM) {
            const int pn = u.pn;
            if (pn >= 16 && pn < 20) {
                float* U = (float*)(ws + W_U); float* out = KOUT(); const int cb = (pn - 16) * 128 + ct;
#pragma unroll
                for (int ai = 0; ai < 2; ++ai)
#pragma unroll
                    for (int m = 0; m < 4; ++m) { const int row = rt + ai * HALF + m * 16; f32x4 r0, r1;
#pragma unroll
                        for (int e = 0; e < 4; ++e) { r0[e] = acc[ai][0][m][0][e] * sigmoidf(acc[ai][1][m][0][e]); r1[e] = acc[ai][0][m][1][e] * sigmoidf(acc[ai][1][m][1][e]); }
                        float* d = U + (size_t)row * CCH + cb; *(f32x4*)d = r0; *(f32x4*)(d + 4) = r1;
                        if (row < MP) { const int s = row & (SEQ - 1); if (s >= SEQ - 30) { float* o = out + O_CVP + ((size_t)(li * BATCH + (row >> 12)) * 30 + (s - (SEQ - 30))) * CCH + cb; *(f32x4*)o = r0; *(f32x4*)(o + 4) = r1; } }
                        else if (row < MT) { const int b = (row - MP) >> 3, t = (row - MP) & 7; float* o = out + O_CVS + ((size_t)(li * DB + b) * 30 + 22 + t) * CCH + cb; *(f32x4*)o = r0; *(f32x4*)(o + 4) = r1; } }
            } else {
                size_t dsto; int ld, cofs, act; size_t fo_p = 0, fo_s = 0; bool f32o = false;
                if (pn < 4) { dsto = W_QB; ld = 1024; cofs = pn * 256; act = 1; }
                else if (pn < 8) { dsto = W_KD; ld = 0; cofs = (pn - 4) * 256; act = 0; f32o = true; fo_p = O_AKP; fo_s = O_AKS; }
                else if (pn < 12) { dsto = W_VD; ld = 0; cofs = (pn - 8) * 256; act = 0; f32o = true; fo_p = O_AVP; fo_s = O_AVS; }
                else if (pn < 16) { dsto = W_GAB; ld = 1024; cofs = (pn - 12) * 256; act = 2; }
                else if (pn < 22) { dsto = W_GCB; ld = 512; cofs = (pn - 20) * 256; act = 2; }
                else if (pn < 24) { dsto = W_QMB; ld = 512; cofs = (pn - 22) * 256; act = 1; }
                else { dsto = W_GMB; ld = 512; cofs = (pn - 24) * 256; act = 2; }
                bf16_t* D = (bf16_t*)(ws + dsto); float* out = KOUT();
#pragma unroll
                for (int ai = 0; ai < 2; ++ai)
#pragma unroll
                    for (int m = 0; m < 4; ++m) { const int row = rt + ai * HALF + m * 16;
#pragma unroll
                        for (int bj = 0; bj < 2; ++bj) { f32x4 v0 = acc[ai][bj][m][0], v1 = acc[ai][bj][m][1]; const int col = cofs + bj * HALF + ct;
                            if (f32o) {
                                if (row < MP) { const int s = row & (SEQ - 1); if (s >= SEQ - WIN) { float* o = out + fo_p + ((size_t)(li * BATCH + (row >> 12)) * WIN + (s - (SEQ - WIN))) * 1024 + col; *(f32x4*)o = v0; *(f32x4*)(o + 4) = v1; } }
                                else if (row < MT) { const int b = (row - MP) >> 3, t = (row - MP) & 7; float* o = out + fo_s + ((size_t)(li * DB + b) * WIN + (WIN - DS) + t) * 1024 + col; *(f32x4*)o = v0; *(f32x4*)(o + 4) = v1; } }
                            if (act == 1) { v0 = v0 * QS; v1 = v1 * QS; }
                            else if (act == 2) {
#pragma unroll
                                for (int e = 0; e < 4; ++e) { v0[e] = silu(v0[e]); v1[e] = silu(v1[e]); } }
                            if (ld) *(v4u*)(D + (size_t)row * ld + col) = pack8(v0, v1);
                            else if (row < MP) {
                                const v4u w = pack8(v0, v1); const int bh = (row >> 12) * NH + (col >> 7), pos = row & (SEQ - 1), dh = col & 127;
                                *(v4u*)(D + ((size_t)bh * SEQ + pos) * HD + dh) = w; } } }
            }
        } else if (mode == 2) {
            bf16_t* Y = (bf16_t*)(ws + W_Y); float* YSQ = (float*)(ws + W_YSQ);
#pragma unroll
            for (int ai = 0; ai < 2; ++ai)
#pragma unroll
                for (int m = 0; m < 4; ++m) { const int row = rt + ai * HALF + m * 16; float s = 0.f;
#pragma unroll
                    for (int bj = 0; bj < 2; ++bj) { const f32x4 v0 = acc[ai][bj][m][0], v1 = acc[ai][bj][m][1];
                        *(v4u*)(Y + (size_t)row * DM + u.pn * BM + bj * HALF + ct) = pack8(v0, v1);
                        s += (v0[0] * v0[0] + v0[1] * v0[1]) + (v0[2] * v0[2] + v0[3] * v0[3]) + (v1[0] * v1[0] + v1[1] * v1[1]) + (v1[2] * v1[2] + v1[3] * v1[3]); }
                    s += __shfl_xor(s, 16); s += __shfl_xor(s, 32);
                    if (fq == 0) YSQ[(size_t)row * 32 + u.pn * 4 + wc] = s; }
        } else if (mode == 3) {
            const bf16_t* G = (const bf16_t*)(ws + W_GCB); bf16_t* MIX = (bf16_t*)(ws + W_MIX);
#pragma unroll
            for (int ai = 0; ai < 2; ++ai)
#pragma unroll
                for (int m = 0; m < 4; ++m) { const int row = rt + ai * HALF + m * 16;
#pragma unroll
                    for (int bj = 0; bj < 2; ++bj) { const int col = u.pn * BM + bj * HALF + ct; const v4u g = *(const v4u*)(G + (size_t)row * CCH + col);
                        f32x4 v0 = acc[ai][bj][m][0], v1 = acc[ai][bj][m][1];
                        v0[0] *= bflo(g.x); v0[1] *= bfhi(g.x); v0[2] *= bflo(g.y); v0[3] *= bfhi(g.y); v1[0] *= bflo(g.z); v1[1] *= bfhi(g.z); v1[2] *= bflo(g.w); v1[3] *= bfhi(g.w);
                        *(v4u*)(MIX + (size_t)row * MIXW + 1024 + col) = pack8(v0, v1); } }
        } else {
            const int pnm = u.pn - INW / BM, layer = pnm >> 2, q = pnm & 3, isv = q >> 1; float* out = KOUT() + (isv ? O_MVP : O_MKP); bf16_t* D = (bf16_t*)(ws + (isv ? W_MVB : W_MKB));
#pragma unroll
            for (int ai = 0; ai < 2; ++ai)
#pragma unroll
                for (int m = 0; m < 4; ++m) { const int row = rt - MPAD + ai * HALF + m * 16;
#pragma unroll
                    for (int bj = 0; bj < 2; ++bj) { const size_t o = ((size_t)layer * 512 + row) * 512 + (q & 1) * 256 + bj * HALF + ct; const f32x4 v0 = acc[ai][bj][m][0], v1 = acc[ai][bj][m][1];
                        *(f32x4*)(out + o) = v0; *(f32x4*)(out + o + 4) = v1; *(v4u*)(D + o) = pack8(v0, v1); } }
        }
    }
};
}
__device__ __forceinline__ void transpose_item(const float* __restrict__ W, const float* __restrict__ g, int K, int N, bf16_t* __restrict__ WT, float* scr, int item, int lane, bool glu) {
    const int nblk = N / 32, kb = item / nblk, nb = item % nblk, k0 = 64 * kb, n0 = 32 * nb;
    int d0 = n0;
    if (glu && n0 >= 4096 && n0 < 5120) { const int isg = n0 >= 4608, r = n0 - (isg ? 4608 : 4096); d0 = 4096 + (r >> 7) * 256 + isg * 128 + (r & 127); }
    float wv[32];
#pragma unroll
    for (int i = 0; i < 32; ++i) wv[i] = __builtin_nontemporal_load(W + (size_t)(k0 + 2 * i + (lane >> 5)) * N + n0 + (lane & 31));
#pragma unroll
    for (int i = 0; i < 32; ++i) { const int kk = 2 * i + (lane >> 5); float v = wv[i]; if (g) v *= g[k0 + kk]; scr[kk * 33 + (lane & 31)] = v; }
    asm volatile("s_waitcnt lgkmcnt(0)" ::: "memory");
    const int c = lane & 7;
#pragma unroll
    for (int j = 0; j < 4; ++j) { const int n = (lane >> 3) + 8 * j; const float* s = scr + (8 * c) * 33 + n;
        v4u o; o.x = pk2(s[0 * 33], s[1 * 33]); o.y = pk2(s[2 * 33], s[3 * 33]); o.z = pk2(s[4 * 33], s[5 * 33]); o.w = pk2(s[6 * 33], s[7 * 33]);
        *(v4u*)(WT + (size_t)(d0 + n) * K + k0 + 8 * c) = o; }
    asm volatile("s_waitcnt lgkmcnt(0)" ::: "memory");
}

constexpr int I_IN = (DM / 64) * (INW / 32), I_OUT = (MIXW / 64) * (DM / 32), I_PW = (CCH / 64) * (CCH / 32), I_MKV = (DM / 64) * (1024 / 32);
constexpr int W_ITEMS = I_IN + I_OUT + I_PW;
constexpr size_t CH4 = (size_t)(WIN - DS) * 1024 / 4;
constexpr int C_ITEMS = (int)((size_t)DEPTH * DB * CH4 / 1024);
static_assert((size_t)C_ITEMS * 1024 == (size_t)DEPTH * DB * CH4, "cache shift items");
__device__ __forceinline__ void w_item(int L, int r, float* scr, int lane) {
  if (r < I_IN) { transpose_item(KIN(I_WIN) + (size_t)L * DM * INW, KIN(I_GPRE) + L * DM, DM, INW, WIN_L(L), scr, r, lane, true); return; } r -= I_IN;
  if (r < I_OUT) { transpose_item(KIN(I_WOUT) + (size_t)L * MIXW * DM, nullptr, MIXW, DM, WSP(bf16_t, W_WOUT) + (size_t)L * DM * MIXW, scr, r, lane, false); return; } r -= I_OUT;
  transpose_item(KIN(I_WPW) + (size_t)L * CCH * CCH, nullptr, CCH, CCH, WSP(bf16_t, W_WPW) + (size_t)L * CCH * CCH, scr, r, lane, false);
}
__device__ __forceinline__ void c_item(int q, int lane) {
  const f4* ck = (const f4*)KIN(I_CK); const f4* cv = (const f4*)KIN(I_CV); f4* ok = (f4*)(KOUT() + O_AKS); f4* ov = (f4*)(KOUT() + O_AVS);
  const size_t i0 = (size_t)q * 1024; const size_t lb = i0 / CH4, r0 = i0 % CH4;
  const size_t so = lb * ((size_t)WIN * 256) + DS * 256 + r0 + lane, dof = lb * ((size_t)WIN * 256) + r0 + lane;
  f4 a[8], b[8];
#pragma unroll
  for (int h = 0; h < 2; ++h) {
#pragma unroll
    for (int j = 0; j < 8; ++j) { a[j] = __builtin_nontemporal_load(ck + so + (h * 8 + j) * 64); b[j] = __builtin_nontemporal_load(cv + so + (h * 8 + j) * 64); }
#pragma unroll
    for (int j = 0; j < 8; ++j) { __builtin_nontemporal_store(a[j], ok + dof + (h * 8 + j) * 64); __builtin_nontemporal_store(b[j], ov + dof + (h * 8 + j) * 64); } }
}
static_assert(CH4 % 1024 == 0, "cache shift item size");
constexpr int NSLOT_W = 3312;
__device__ __forceinline__ void ph_filler(int li, int vs0, int nv, int nvs, float* lds_f, int wave_s) {
  OPAQUE_IDS
  const int lane = tid_ & 63; float* scr = lds_f + wave_s * (64 * 33);
  constexpr int CQ = C_ITEMS / DEPTH;
  for (int v = vs0; v < vs0 + nv; ++v) {
    if (li + 1 < DEPTH) for (int r = v; r < W_ITEMS; r += nvs) w_item(li + 1, r, scr, lane);
#ifndef COPY_IN_PROLOGUE
    for (int q = v; q < CQ; q += nvs) c_item(li * CQ + q, lane);
#endif
  }
}
static_assert(C_ITEMS % DEPTH == 0, "cache shift quarter");

__device__ __forceinline__ void ph_prologue(float* lds_f, int wave_s) {
  OPAQUE_IDS
  const int lane = tid_ & 63, wave = tid_ >> 6;
  float* scr = lds_f + wave * (64 * 33);
  for (int it = GW; it < W_ITEMS + DEPTH * I_MKV; it += NGW) {
    if (it < W_ITEMS) w_item(0, it, scr, lane);
    else { const int r = it - W_ITEMS, L = r / I_MKV; transpose_item(KIN(I_WMKV) + (size_t)L * DM * 1024, nullptr, DM, 1024, WSP(bf16_t, W_WMKV) + (size_t)L * 1024 * DM, scr, r % I_MKV, lane, false); }
  }
#ifdef COPY_IN_PROLOGUE
  for (int q = GW; q < C_ITEMS; q += NGW) c_item(q, lane);
#endif
  { const float* mem_prompt = KIN(I_MEM); bf16_t* memb = WSP(bf16_t, W_MEMB);
    for (size_t i = GT; i < (size_t)512 * DM; i += NGT) memb[i] = (bf16_t)f2bf(mem_prompt[i]); }
  {
    const f4* ck = (const f4*)KIN(I_CMK); const f4* cv = (const f4*)KIN(I_CMV); unsigned long long* ok = WSP(unsigned long long, W_CMKB); unsigned long long* ov = WSP(unsigned long long, W_CMVB);
    for (size_t i = GT; i < (size_t)DEPTH * DB * NMEM * 512 / 4; i += NGT) { const f4 a = ck[i], b = cv[i];
      ok[i] = (unsigned long long)pk2(a[0], a[1]) | ((unsigned long long)pk2(a[2], a[3]) << 32); ov[i] = (unsigned long long)pk2(b[0], b[1]) | ((unsigned long long)pk2(b[2], b[3]) << 32); } }
  {
    const float* xp = KIN(I_XP); const float* xs = KIN(I_XS); bf16_t* xa = WSP(bf16_t, W_XA);
    for (int w = MT + GW; w < MPAD; w += NGW) { unsigned long long* o = (unsigned long long*)(xa + (size_t)w * DM); for (int j = 0; j < 8; ++j) o[lane + 64 * j] = 0ull; }
#define PR_XR(w) ((const f4*)(((w) < MP) ? xp + (size_t)(w) * DM : xs + (size_t)((w) - MP) * DM))
    int w = GW;
    if (w < MT) {
      f4 v[8];
#pragma unroll
      for (int j = 0; j < 8; ++j) v[j] = PR_XR(w)[lane + 64 * j];
      for (;;) {
        const int wn = w + NGW; const bool more = wn < MT; f4 vn[8];
        if (more) {
#pragma unroll
          for (int j = 0; j < 8; ++j) vn[j] = PR_XR(wn)[lane + 64 * j]; }
        float s = 0.f;
#pragma unroll
        for (int j = 0; j < 8; ++j) s += (v[j][0] * v[j][0] + v[j][1] * v[j][1]) + (v[j][2] * v[j][2] + v[j][3] * v[j][3]);
        const float rstd = rsqrtf(wave_sum(s) / DM + EPS); unsigned long long* o = (unsigned long long*)(xa + (size_t)w * DM);
#pragma unroll
        for (int j = 0; j < 8; ++j) o[lane + 64 * j] = (unsigned long long)pk2(v[j][0] * rstd, v[j][1] * rstd) | ((unsigned long long)pk2(v[j][2] * rstd, v[j][3] * rstd) << 32);
        if (!more) break;
        w = wn;
#pragma unroll
        for (int j = 0; j < 8; ++j) v[j] = vn[j];
      }
    }
#undef PR_XR
  }
  {
    const float* st = KIN(I_ST); float* o = KOUT() + O_CVS;
    for (size_t i = GT; i < (size_t)DEPTH * DB * 22 * CCH; i += NGT) { const size_t lb = i / (22 * CCH), r = i % (22 * CCH); o[lb * 30 * CCH + r] = st[lb * 30 * CCH + 8 * CCH + r]; } }
}

namespace att {
using bf16x8 = __attribute__((ext_vector_type(8))) short;
using s16x4  = __attribute__((ext_vector_type(4))) short;
using f32x16 = __attribute__((ext_vector_type(16))) float;
using u32x4  = __attribute__((ext_vector_type(4))) unsigned;
using f32x8  = __attribute__((ext_vector_type(8))) float;
constexpr int TBL_N = 192, TBL_O = 32, LDS_TBL = 131072, LDS_WSF = LDS_TBL + 3 * NH * TBL_N * 4;
static_assert(LDS_WSF + 8 * 128 * 4 <= LDS_MISC && LDS_MISC + 64 <= LDS_BYTES, "attention LDS map");
constexpr float THR = 4.f;
#define KSWZ(row, colB) ((row) * 256 + ((colB) ^ (((row) & 7) << 4)))
#define SBAR() __builtin_amdgcn_sched_barrier(0)
__device__ __forceinline__ int crow(int r, int hi) { return (r & 3) + 8 * (r >> 2) + 4 * hi; }
__device__ __forceinline__ unsigned cvtpk(float lo, float hi) { unsigned r; asm volatile("v_cvt_pk_bf16_f32 %0, %1, %2" : "=v"(r) : "v"(lo), "v"(hi)); return r; }
__device__ __forceinline__ int v_st(int k, int c) { const int kk = (k & ~0xC) | ((k & 4) << 1) | ((k & 8) >> 1); return ((kk >> 3) * 4 + (c >> 5)) * 512 + ((kk & 7) * 32 + (c & 31)) * 2; }
__device__ __forceinline__ int v_rd_base(int lane) { return ((lane & 3) << 3) | (((lane >> 2) & 3) << 6) | (((lane >> 4) & 1) << 5) | (((lane >> 5) & 1) << 8); }
constexpr int v_rd_off(int d0, int ks, int half) { return d0 * 512 + ks * 4096 + half * 2048; }
template <int OFF> __device__ __forceinline__ s16x4 tr_read(int vb) { s16x4 r; asm volatile("ds_read_b64_tr_b16 %0, %1 offset:%2" : "=&v"(r) : "v"(vb), "i"(OFF) : "memory"); return r; }
template <int D0> __device__ __forceinline__ void pv_one(f32x16& od, int vb, bf16x8 pa0, bf16x8 pa1) {
  const s16x4 l0 = tr_read<v_rd_off(D0, 0, 0)>(vb), h0 = tr_read<v_rd_off(D0, 0, 1)>(vb), l1 = tr_read<v_rd_off(D0, 1, 0)>(vb), h1 = tr_read<v_rd_off(D0, 1, 1)>(vb);
  asm volatile("s_waitcnt lgkmcnt(0)" ::: "memory"); SBAR();
#define PK(L, H) (bf16x8){L[0], L[1], L[2], L[3], H[0], H[1], H[2], H[3]}
  od = __builtin_amdgcn_mfma_f32_32x32x16_bf16(pa0, PK(l0, h0), od, 0, 0, 0);
  od = __builtin_amdgcn_mfma_f32_32x32x16_bf16(pa1, PK(l1, h1), od, 0, 0, 0);
#undef PK
}
__device__ __forceinline__ bf16x8 tobf(f32x8 x) { u32x4 w = {cvtpk(x[0], x[1]), cvtpk(x[2], x[3]), cvtpk(x[4], x[5]), cvtpk(x[6], x[7])}; return __builtin_bit_cast(bf16x8, w); }

struct Task {
  int row0, rstep, head;
  const bf16_t *Kb, *Vb;
  const float *Kc, *Vc, *Kn, *Vn;
  int q0, t0, pat, pend, nrows, rs;
};
template <bool SAMPLE, bool CROSS, int OUT>
__device__ __forceinline__ void wave_task(char* lds, int wave, int lane_in, const Task& T) {
  int lane = lane_in; asm volatile("" : "+v"(lane));
  const int r32 = lane & 31, hi = lane >> 5, rsub = lane >> 4, ch = lane & 15;
  char* Kl = lds + wave * 16384; char* Vl = Kl + 8192;
  float* wsf = (float*)(lds + LDS_WSF) + wave * 128;
  const int vb = (int)(unsigned)(uintptr_t)Vl + v_rd_base(lane);
  bf16x8 qr[8];
  { const bf16_t* Q0 = CROSS ? WSP(bf16_t, W_QMB) + (size_t)T.row0 * 512 + T.head * HD : WSP(bf16_t, W_QB) + (size_t)T.row0 * 1024 + T.head * HD; const int qstride = T.rstep * (CROSS ? 512 : 1024);
#pragma unroll
    for (int d0 = 0; d0 < 8; ++d0) qr[d0] = *(const bf16x8*)(Q0 + r32 * qstride + d0 * 16 + hi * 8); }
  float m_reg = -1e30f, l_reg = 0.f; f32x16 o[4] = {};
  const int RS = CROSS ? 1024 : T.rs;
  bf16x8 kst[8], vst[8];
  const int loff = rsub * RS + ch * 16;
#define LOAD_T(t) do { const char* kp_ = (const char*)T.Kb + (size_t)(t) * (32 * RS) + loff; const char* vp_ = (const char*)T.Vb + (size_t)(t) * (32 * RS) + loff; \
    _Pragma("unroll") for (int c = 0; c < 8; ++c) { kst[c] = *(const bf16x8*)(kp_ + c * 4 * RS); vst[c] = *(const bf16x8*)(vp_ + c * 4 * RS); } } while (0)
#define WRITE_T() do { _Pragma("unroll") for (int c = 0; c < 8; ++c) { *(bf16x8*)(Kl + KSWZ(4 * c + rsub, ch * 16)) = kst[c]; *(bf16x8*)(Vl + v_st(4 * c + rsub, ch * 8)) = vst[c]; } } while (0)
#define DIRECT_TILE(d, t) do { _Pragma("unroll") for (int c = 0; c < 8; ++c) { const int row = 4 * c + rsub; int pos = T.q0 + (32 * (t) + row - 128) * (d); pos = pos < 0 ? 0 : (pos > WIN + DS - 1 ? WIN + DS - 1 : pos); \
      const float* kr = (CROSS || pos < WIN) ? T.Kc + (size_t)pos * (CROSS ? 512 : 1024) : T.Kn + (size_t)(pos - DS) * 1024; const float* vr = (CROSS || pos < WIN) ? T.Vc + (size_t)pos * (CROSS ? 512 : 1024) : T.Vn + (size_t)(pos - DS) * 1024; \
      const f32x8 kf = *(const f32x8*)(kr + ch * 8), vf = *(const f32x8*)(vr + ch * 8); *(bf16x8*)(Kl + KSWZ(row, ch * 16)) = tobf(kf); *(bf16x8*)(Vl + v_st(row, ch * 8)) = tobf(vf); if ((c & 3) == 3) SBAR(); } } while (0)
  constexpr int NTL = CROSS ? NMEM / 32 : 5;
  int pi = T.pat, t = SAMPLE ? 0 : T.t0;
  if constexpr (!SAMPLE) LOAD_T(t);
  for (;;) {
    if constexpr (!SAMPLE) WRITE_T();
    else { if constexpr (CROSS) { const int q0s = 128; (void)q0s; }
           const int d = CROSS ? 1 : (pi == 0 ? 1 : pi == 1 ? 4 : 16); DIRECT_TILE(d, t); }
    int pin = pi, tn = t + 1;
    if (tn >= NTL) { tn = 0; pin = pi + 1; }
    const bool more = (SAMPLE && !CROSS) ? (pin < T.pend) : (tn != 0);
    if constexpr (!SAMPLE) { if (more) LOAD_T(tn); }
    f32x16 p0 = {};
#pragma unroll
    for (int d0 = 0; d0 < 8; ++d0) { const bf16x8 a = *(const bf16x8*)(Kl + KSWZ(r32, (d0 * 16 + hi * 8) * 2)); p0 = __builtin_amdgcn_mfma_f32_32x32x16_bf16(a, qr[d0], p0, 0, 0, 0); }
    if constexpr (!CROSS) { const float* tp = (const float*)(lds + LDS_TBL) + (pi * NH + T.head) * TBL_N + TBL_O + 32 * t + 4 * hi - (SAMPLE ? 0 : r32);
#pragma unroll
      for (int r = 0; r < 16; ++r) p0[r] += tp[(r & 3) + 8 * (r >> 2)]; }
    float pmax = p0[0];
#pragma unroll
    for (int r = 1; r < 16; ++r) pmax = fmaxf(pmax, p0[r]);
    { auto rr = __builtin_amdgcn_permlane32_swap(__float_as_uint(pmax), __float_as_uint(pmax), false, false); pmax = fmaxf(__uint_as_float(rr[0]), __uint_as_float(rr[1])); }
    float alpha = 1.f;
    if (!__all(pmax - m_reg <= THR)) { const float mn = fmaxf(m_reg, pmax); alpha = __builtin_amdgcn_exp2f(m_reg - mn); m_reg = mn;
      if (hi == 0) wsf[r32] = alpha; asm volatile("s_waitcnt lgkmcnt(0)" ::: "memory");
#pragma unroll
      for (int d = 0; d < 4; ++d)
#pragma unroll
        for (int r = 0; r < 16; ++r) o[d][r] *= wsf[crow(r, hi)]; }
    float ps = 0.f;
#pragma unroll
    for (int r = 0; r < 16; ++r) { p0[r] = __builtin_amdgcn_exp2f(p0[r] - m_reg); ps += p0[r]; }
    { auto rr = __builtin_amdgcn_permlane32_swap(__float_as_uint(ps), __float_as_uint(ps), false, false); ps = __uint_as_float(rr[0]) + __uint_as_float(rr[1]); }
    l_reg = l_reg * alpha + ps;
    bf16x8 pa0, pa1;
#define PK4(PP, BASE, OUT_) do { unsigned a0 = cvtpk(PP[BASE + 0], PP[BASE + 1]), a1 = cvtpk(PP[BASE + 2], PP[BASE + 3]), b0 = cvtpk(PP[BASE + 4], PP[BASE + 5]), b1 = cvtpk(PP[BASE + 6], PP[BASE + 7]); \
    auto r0 = __builtin_amdgcn_permlane32_swap(a0, b0, false, false); auto r1 = __builtin_amdgcn_permlane32_swap(a1, b1, false, false); \
    u32x4 w = {r0[0], r1[0], r0[1], r1[1]}; OUT_ = __builtin_bit_cast(bf16x8, w); } while (0)
    PK4(p0, 0, pa0); PK4(p0, 8, pa1);
#undef PK4
    SBAR();
    pv_one<0>(o[0], vb, pa0, pa1); pv_one<1>(o[1], vb, pa0, pa1); pv_one<2>(o[2], vb, pa0, pa1); pv_one<3>(o[3], vb, pa0, pa1);
    if (!more) break;
    pi = pin; t = tn;
  }
#undef LOAD_T
#undef WRITE_T
#undef DIRECT_TILE
  int lane_e = lane; asm volatile("" : "+v"(lane_e)); const int r32e = lane_e & 31, hie = lane_e >> 5;
  float fa = __builtin_amdgcn_rcpf(l_reg), fb = 0.f, fc = 0.f;
  const int nrows = T.nrows, rstep = T.rstep;
  if constexpr (OUT == 1) { if (hie == 0 && r32e < nrows) { float* Pm = (float*)((char*)WSP(float, W_PM) + T.pat * PM_BYTES) + (size_t)T.row0 * NH + T.head; float* Pl = (float*)((char*)WSP(float, W_PL) + T.pat * PM_BYTES) + (size_t)T.row0 * NH + T.head;
      Pm[r32e * rstep * NH] = m_reg; Pl[r32e * rstep * NH] = l_reg; } }
  if constexpr (OUT == 2) { const float* Pm = WSP(float, W_PM) + (size_t)T.row0 * NH + T.head; const float* Pl = WSP(float, W_PL) + (size_t)T.row0 * NH + T.head; const int po = r32e * rstep * NH;
    const float m1 = Pm[po], l1 = Pl[po], m2 = Pm[PM_BYTES / 4 + po], l2 = Pl[PM_BYTES / 4 + po]; const float M = fmaxf(m_reg, fmaxf(m1, m2));
    const float a = __builtin_amdgcn_exp2f(m_reg - M), a1 = __builtin_amdgcn_exp2f(m1 - M) * l1, a2 = __builtin_amdgcn_exp2f(m2 - M) * l2; const float inv = __builtin_amdgcn_rcpf(l_reg * a + a1 + a2); fa = a * inv; fb = a1 * inv; fc = a2 * inv; }
  if (hie == 0) { wsf[r32e] = fa; wsf[32 + r32e] = fb; wsf[64 + r32e] = fc; } asm volatile("s_waitcnt lgkmcnt(0)" ::: "memory");
  const int rse = lane_e >> 4, che = lane_e & 15;
  bf16_t* Po = (bf16_t*)((char*)WSP(bf16_t, W_PO) + (OUT == 1 ? T.pat : 0) * PO_BYTES) + (size_t)T.row0 * 1024 + T.head * HD + che * 8; const int pstride = rstep * 1024;
  bf16_t* Mx = WSP(bf16_t, W_MIX) + (size_t)T.row0 * MIXW + (CROSS ? 1536 : 0) + T.head * HD + che * 8; const int mstride = rstep * MIXW;
  const bf16_t* Gx = (CROSS ? WSP(bf16_t, W_GMB) + (size_t)T.row0 * 512 + T.head * HD : WSP(bf16_t, W_GAB) + (size_t)T.row0 * 1024 + T.head * HD) + che * 8; const int gstride = rstep * (CROSS ? 512 : 1024);
  v4u gq[8], p1q[8], p2q[8];
  if constexpr (OUT != 1) {
#pragma unroll
    for (int c = 0; c < 8; ++c) { const int row = 4 * c + rse; if (row < nrows) { gq[c] = *(const v4u*)(Gx + row * gstride);
        if constexpr (OUT == 2) { p1q[c] = *(const v4u*)(Po + row * pstride); p2q[c] = *(const v4u*)(Po + PO_BYTES / 2 + row * pstride); } } } }
  float* so = (float*)Kl;
#pragma unroll
  for (int r = 0; r < 16; ++r) { const int orow = crow(r, hie); const float ra = wsf[orow];
#pragma unroll
    for (int d0 = 0; d0 < 4; ++d0) so[orow * 128 + d0 * 32 + r32e] = o[d0][r] * ra; }
  asm volatile("s_waitcnt lgkmcnt(0)" ::: "memory");
#pragma unroll
  for (int c = 0; c < 8; ++c) { const int row = 4 * c + rse;
    if (row < nrows) {
      f4 x0 = *(const f4*)(so + row * 128 + che * 8), x1 = *(const f4*)(so + row * 128 + che * 8 + 4);
      if constexpr (OUT == 1) { v4u w; w.x = pk2(x0[0], x0[1]); w.y = pk2(x0[2], x0[3]); w.z = pk2(x1[0], x1[1]); w.w = pk2(x1[2], x1[3]); *(v4u*)(Po + row * pstride) = w; }
      else {
        if constexpr (OUT == 2) { const float rb = wsf[32 + row], rc = wsf[64 + row]; const v4u p1 = p1q[c], p2 = p2q[c];
          x0[0] += bflo(p1.x) * rb + bflo(p2.x) * rc; x0[1] += bfhi(p1.x) * rb + bfhi(p2.x) * rc; x0[2] += bflo(p1.y) * rb + bflo(p2.y) * rc; x0[3] += bfhi(p1.y) * rb + bfhi(p2.y) * rc;
          x1[0] += bflo(p1.z) * rb + bflo(p2.z) * rc; x1[1] += bfhi(p1.z) * rb + bfhi(p2.z) * rc; x1[2] += bflo(p1.w) * rb + bflo(p2.w) * rc; x1[3] += bfhi(p1.w) * rb + bfhi(p2.w) * rc; }
        const v4u g = gq[c];
        v4u w; w.x = pk2(x0[0] * bflo(g.x), x0[1] * bfhi(g.x)); w.y = pk2(x0[2] * bflo(g.y), x0[3] * bfhi(g.y)); w.z = pk2(x1[0] * bflo(g.z), x1[1] * bfhi(g.z)); w.w = pk2(x1[2] * bflo(g.w), x1[3] * bfhi(g.w));
        *(v4u*)(Mx + row * mstride) = w; } } }
  asm volatile("s_waitcnt lgkmcnt(0)" ::: "memory");
}
#undef KSWZ
#undef SBAR
}

__device__ __forceinline__ void build_bias_tables(char* lds, int wave_s) {
  OPAQUE_IDS
  const float* rel_bias = KIN(I_RB); float* tbl = (float*)(lds + att::LDS_TBL);
  for (int i = tid_; i < 3 * NH * att::TBL_N; i += NT) { const int p = i / (NH * att::TBL_N), h = (i / att::TBL_N) % NH, x = i % att::TBL_N - att::TBL_O;
    tbl[i] = (x >= 0 && x <= 128) ? rel_bias[BUCKET[p][128 - x] * NH + h] * LOG2E : -INFINITY; }
}
__device__ __forceinline__ att::Task prompt_task(int pat, int b, int h, int r, int i0) {
  const int d = (pat == 0) ? 1 : (pat == 1) ? 4 : 16;
  att::Task T{}; T.row0 = b * SEQ + r + d * i0; T.rstep = d; T.head = h; T.pat = pat; T.nrows = 32; T.t0 = i0 >= 128 ? 0 : (128 - i0) >> 5;
  const size_t e0 = ((size_t)(b * NH + h) * SEQ + r + (size_t)d * i0) * HD;
  T.rs = 256 * d;
  T.Kb = WSP(bf16_t, W_KD) + e0 - (size_t)128 * d * HD; T.Vb = WSP(bf16_t, W_VD) + e0 - (size_t)128 * d * HD;
  return T;
}
__device__ __forceinline__ att::Task sample_task(int li, int b, int h, int t, int pbeg, int pend) {
  att::Task T{}; const size_t cb = ((size_t)(li * DB + b) * WIN) * 1024 + h * HD;
  T.row0 = MP + b * DS + t; T.rstep = 0; T.head = h; T.Kc = KIN(I_CK) + cb; T.Vc = KIN(I_CV) + cb; T.Kn = KOUT() + O_AKS + cb; T.Vn = KOUT() + O_AVS + cb;
  T.q0 = WIN + t; T.nrows = 1; T.pat = pbeg; T.pend = pend;
  return T;
}
__device__ __forceinline__ void cross_tasks(int li, char* lds, int wave, int lane, int t_lo, int t_hi, int slot, int nslots) {
  constexpr int NTASK_P = (MP / 32) * NXH;
  for (int tk = t_lo + slot; tk < t_hi; tk += nslots) {
    att::Task T{}; T.rstep = 1; T.t0 = 0; T.pat = 0; T.q0 = 128;
    if (tk < NTASK_P) {
      const int h = tk & 3, rt = tk >> 2, b = rt >> 7; const size_t kvo = ((size_t)li * 512 + b * NMEM) * 512 + h * HD;
      T.row0 = rt * 32; T.head = h; T.Kb = WSP(bf16_t, W_MKB) + kvo; T.Vb = WSP(bf16_t, W_MVB) + kvo; T.nrows = 32;
      att::wave_task<false, true, 0>(lds, wave, lane, T);
    } else {
      const int h = (tk - NTASK_P) & 3, b = (tk - NTASK_P) >> 2; const size_t kvo = ((size_t)(li * DB + b) * NMEM) * 512 + h * HD;
      T.row0 = MP + b * DS; T.head = h; T.Kb = WSP(bf16_t, W_CMKB) + kvo; T.Vb = WSP(bf16_t, W_CMVB) + kvo; T.nrows = DS;
      att::wave_task<false, true, 0>(lds, wave, lane, T);
    }
  }
}
__device__ __forceinline__ void ph_attn1(int li, char* lds, int wave_s) {
  OPAQUE_IDS
  const int lane = tid_ & 63, wave = wave_s;
  { const int x = bid_ & 7, j = (bid_ >> 3) * 8 + wave;
    for (int jj = j; jj < 256; jj += (nb_ >> 3) * 8) { const int bh = 2 * x + (jj >> 7), qt = jj & 127;
      { att::Task T = prompt_task(0, bh >> 3, bh & 7, 0, qt * 32); att::wave_task<false, false, 1>(lds, wave, lane, T); }
      { att::Task T = prompt_task(1, bh >> 3, bh & 7, qt >> 5, (qt & 31) * 32); att::wave_task<false, false, 1>(lds, wave, lane, T); } } }
  if (wave < 4) { for (int tk = bid_ * 4 + wave; tk < 2 * DB * NH * DS; tk += nb_ * 4) { const int pat = tk & 1, q = tk >> 1;
      att::Task T = sample_task(li, q >> 6, (q >> 3) & 7, q & 7, pat, pat + 1); att::wave_task<true, false, 1>(lds, wave, lane, T); } }
  else cross_tasks(li, lds, wave, lane, 0, (MP / 32) * NXH, bid_ * 4 + (wave - 4), nb_ * 4);
}
__device__ __forceinline__ void ph_attn2(int li, char* lds, int wave_s) {
  OPAQUE_IDS
  const int lane = tid_ & 63, wave = wave_s;
  const int x = bid_ & 7, j = (bid_ >> 3) * 8 + wave;
  for (int jj = j; jj < 256; jj += (nb_ >> 3) * 8) { const int bh = 2 * x + (jj >> 7), r16 = (jj >> 3) & 15, it = jj & 7;
    att::Task T = prompt_task(2, bh >> 3, bh & 7, r16, it * 32);
    att::wave_task<false, false, 2>(lds, wave, lane, T); }
  { const int skip = (nb_ > 132) ? 66 : 0, nbs = nb_ - skip, vb_ = bid_ - skip;
    if (vb_ >= 0) for (int q = wave * nbs + vb_; q < DB * NH * DS; q += 8 * nbs) {
        att::Task T = sample_task(li, q >> 6, (q >> 3) & 7, q & 7, 2, 3); att::wave_task<true, false, 2>(lds, wave, lane, T); } }
  { const int vb2 = (bid_ + nb_ - 130 % nb_) % nb_;
    if (wave == 3) cross_tasks(li, lds, wave, lane, (MP / 32) * NXH, (MP / 32) * NXH + DB * NXH, vb2, nb_); }
}
__device__ __forceinline__ void ph_conv_tiles(int li, char* lds, int wave_s) {
  OPAQUE_IDS
  const int c = tid_, lane = tid_ & 63, wave = tid_ >> 6;
  const float* u = WSP(float, W_U); const float* state = KIN(I_ST) + (size_t)li * DB * 30 * CCH; const float* wdw = KIN(I_WDW) + (size_t)li * CK * CCH;
  const float* lg = KIN(I_LNG) + li * CCH; const float* lb = KIN(I_LNB) + li * CCH; bf16_t* cact = WSP(bf16_t, W_CACT);
  float* tile = (float*)lds;
  for (int tl = bid_; tl < MP / 32 + DB; tl += nb_) {
    const bool samp = tl >= MP / 32;
    const int ntok = samp ? DS : 32;
    float win[62];
    if (!samp) { const int t0 = (tl * 32) & (SEQ - 1); const float* ub = u + (size_t)(tl * 32 - 30) * CCH + c;
#pragma unroll
      for (int k = 0; k < 62; ++k) win[k] = (t0 - 30 + k >= 0) ? ub[(size_t)k * CCH] : 0.f; }
    else { const int b = tl - MP / 32; const float* sb = state + (size_t)b * 30 * CCH + c; const float* ub = u + (size_t)(MP + b * DS) * CCH + c;
#pragma unroll
      for (int k = 0; k < 62; ++k) win[k] = (k < 30) ? sb[(size_t)k * CCH] : (k < 30 + DS ? ub[(size_t)(k - 30) * CCH] : 0.f); }
    float w[CK];
#pragma unroll
    for (int k = 0; k < CK; ++k) w[k] = wdw[k * CCH + c];
    const float bias = KIN(I_BDW)[li * CCH + c];
    __syncthreads();
#pragma unroll
    for (int t = 0; t < 32; ++t) { if (t < ntok) { float a = bias;
#pragma unroll
      for (int k = 0; k < CK; ++k) a += w[k] * win[t + k];
      tile[t * CCH + c] = a; } }
    __syncthreads();
#pragma unroll
    for (int j = 0; j < 4; ++j) { const int t = wave * 4 + j;
      if (t < ntok) {
        const f4 v0 = *(const f4*)(tile + t * CCH + lane * 8), v1 = *(const f4*)(tile + t * CCH + lane * 8 + 4);
        const float mean = wave_sum((v0[0] + v0[1]) + (v0[2] + v0[3]) + (v1[0] + v1[1]) + (v1[2] + v1[3])) * (1.f / CCH);
        const f4 d0 = v0 - mean, d1 = v1 - mean;
        const float rstd = rsqrtf(wave_sum((d0[0] * d0[0] + d0[1] * d0[1]) + (d0[2] * d0[2] + d0[3] * d0[3]) + (d1[0] * d1[0] + d1[1] * d1[1]) + (d1[2] * d1[2] + d1[3] * d1[3])) * (1.f / CCH) + EPS);
        const f4 g0 = *(const f4*)(lg + lane * 8), g1 = *(const f4*)(lg + lane * 8 + 4), b0 = *(const f4*)(lb + lane * 8), b1 = *(const f4*)(lb + lane * 8 + 4);
        const f4 y0 = d0 * rstd * g0 + b0, y1 = d1 * rstd * g1 + b1;
        v4u o; o.x = pk2(silu(y0[0]), silu(y0[1])); o.y = pk2(silu(y0[2]), silu(y0[3])); o.z = pk2(silu(y1[0]), silu(y1[1])); o.w = pk2(silu(y1[2]), silu(y1[3]));
        const size_t row = samp ? (size_t)MP + (tl - MP / 32) * DS + t : (size_t)tl * 32 + t;
        *(v4u*)(cact + row * CCH + lane * 8) = o; } }
  }
  __syncthreads();
}

__device__ __forceinline__ void ph_postpre(int li, int wave_s) {
  OPAQUE_IDS
  const int lane = tid_ & 63;
  const bf16_t* y = WSP(bf16_t, W_Y); const float* ysq = WSP(float, W_YSQ);
  float* xcur = WSP(float, W_XCUR); bf16_t* xa = WSP(bf16_t, W_XA); float* out = KOUT(); const float* xp = KIN(I_XP); const float* xs = KIN(I_XS);
  f4 gv[8];
  { const f4* g = (const f4*)(KIN(I_GPOST) + li * DM);
#pragma unroll
    for (int j = 0; j < 8; ++j) gv[j] = g[lane + 64 * j]; }
#define PP_XR(w) ((const f4*)((li == 0) ? (((w) < MP) ? xp + (size_t)(w) * DM : xs + (size_t)((w) - MP) * DM) : xcur + (size_t)(w) * DM))
#define PP_LOAD(w, X, Y, Q) do { const f4* xr_ = PP_XR(w); const unsigned long long* yr_ = (const unsigned long long*)(y + (size_t)(w) * DM); Q = ysq[(size_t)(w) * 32 + (lane & 31)]; \
    _Pragma("unroll") for (int j = 0; j < 8; ++j) { X[j] = xr_[lane + 64 * j]; Y[j] = yr_[lane + 64 * j]; } } while (0)
  int w = GW; if (w >= MT) return;
  f4 xv[8]; unsigned long long yv[8]; float q;
  PP_LOAD(w, xv, yv, q);
  for (;;) {
    const int wn = w + NGW; const bool more = wn < MT;
    f4 xn[8]; unsigned long long yn[8]; float qn = 0.f;
    if (more) PP_LOAD(wn, xn, yn, qn);
    const float rstd_y = rsqrtf(wave_sum(q) * 0.5f / DM + EPS);
    f4* xo = (f4*)((li == DEPTH - 1) ? ((w < MP) ? out + O_YP + (size_t)w * DM : out + O_YS + (size_t)(w - MP) * DM) : xcur + (size_t)w * DM);
    f4 v[8]; float s = 0.f;
#pragma unroll
    for (int j = 0; j < 8; ++j) { const unsigned long long yw = yv[j]; const f4 yf = {bflo((unsigned)yw), bfhi((unsigned)yw), bflo((unsigned)(yw >> 32)), bfhi((unsigned)(yw >> 32))};
      v[j] = xv[j] + yf * rstd_y * gv[j]; xo[lane + 64 * j] = v[j];
      s += (v[j][0] * v[j][0] + v[j][1] * v[j][1]) + (v[j][2] * v[j][2] + v[j][3] * v[j][3]); }
    if (li < DEPTH - 1) {
      const float rstd = rsqrtf(wave_sum(s) / DM + EPS); unsigned long long* o = (unsigned long long*)(xa + (size_t)w * DM);
#pragma unroll
      for (int j = 0; j < 8; ++j) o[lane + 64 * j] = (unsigned long long)pk2(v[j][0] * rstd, v[j][1] * rstd) | ((unsigned long long)pk2(v[j][2] * rstd, v[j][3] * rstd) << 32);
    }
    if (!more) break;
    w = wn; q = qn;
#pragma unroll
    for (int j = 0; j < 8; ++j) { xv[j] = xn[j]; yv[j] = yn[j]; }
  }
#undef PP_LOAD
#undef PP_XR
}

#define XB_TMO      128
#define XB_XCNT(j)  (256  + 64 * (j))
#define XB_XSUB(j)  (1280 + 64 * (j))
#define XB_XGEN(j)  (2304 + 64 * (j))
#define XB_TOP      3328
#define XB_TOPGEN   3392
#define XCD_BAR_WORDS 3456
#define XB_SPIN_CAP (1u << 20)
__device__ __forceinline__ unsigned xb_ld(unsigned* p)              { return __hip_atomic_load(p, __ATOMIC_RELAXED, __HIP_MEMORY_SCOPE_AGENT); }
__device__ __forceinline__ unsigned xb_add(unsigned* p, unsigned v) { return __hip_atomic_fetch_add(p, v, __ATOMIC_RELAXED, __HIP_MEMORY_SCOPE_AGENT); }
__device__ __forceinline__ unsigned xb_xcc_id() { return (unsigned)__builtin_amdgcn_s_getreg((3 << 11) | 20) & 0xFu; }
#define XB_SPIN(cond, bar) do { unsigned _sp = 0; while (cond) { __builtin_amdgcn_s_sleep(1); \
    if ((++_sp & 255u) == 0u) { if (xb_ld(&(bar)[XB_TMO])) break; if (_sp > XB_SPIN_CAP) { atomicAdd(&(bar)[XB_TMO], 1u); break; } } } } while (0)
__device__ __forceinline__ void xcd_barrier_post(unsigned* bar, int wave_s) { if (wave_s == 0 && lane_id_v() == 0) (void)xb_add(&bar[XB_XCNT(xb_xcc_id())], 1u); }
__device__ __forceinline__ void xcd_barrier_complete(unsigned* bar, unsigned x, unsigned G, unsigned& nloc, unsigned& nx) {
    unsigned sum, cnt, mine, sp = 0u;
    for (;;) {
        sum = 0u; cnt = 0u; mine = 0u;
#pragma unroll
        for (unsigned j = 0; j < 16; ++j) { const unsigned c = xb_ld(&bar[XB_XCNT(j)]); sum += c; cnt += (c > 0u) ? 1u : 0u; mine = (j == x) ? c : mine; }
        if (sum == G) break;
        __builtin_amdgcn_s_sleep(1);
        if ((++sp & 255u) == 0u) { if (xb_ld(&bar[XB_TMO])) break; if (sp > XB_SPIN_CAP) { atomicAdd(&bar[XB_TMO], 1u); break; } }
    }
    nloc = mine > 0u ? mine : 1u; nx = cnt > 0u ? cnt : 1u;
}
__device__ __forceinline__ void xcd_barrier(unsigned* bar, volatile LAS unsigned* st, int wave_s) {
    asm volatile("s_waitcnt vmcnt(0)" ::: "memory");
    __syncthreads();
    if (wave_s == 0 && lane_id_v() == 0) {
        __builtin_amdgcn_s_waitcnt(0);
        const unsigned x = xb_xcc_id();
        unsigned nloc = st[0], nx = st[1];
        if (nloc == 0u) { xcd_barrier_complete(bar, x, gridDim.x, nloc, nx); st[0] = nloc; st[1] = nx; }
        const unsigned old = xb_add(&bar[XB_XSUB(x)], 1u);
        const unsigned gen = old / nloc;
        if (old + 1u == (gen + 1u) * nloc) {
            __builtin_amdgcn_fence(__ATOMIC_RELEASE, "agent");
            asm volatile("s_waitcnt vmcnt(0)" ::: "memory");
            const unsigned og = xb_add(&bar[XB_TOP], 1u);
            const unsigned tg = og / nx;
            if (og + 1u == (tg + 1u) * nx) xb_add(&bar[XB_TOPGEN], 1u);
            else XB_SPIN(xb_ld(&bar[XB_TOPGEN]) == tg, bar);
            __builtin_amdgcn_fence(__ATOMIC_ACQUIRE, "agent");
            xb_add(&bar[XB_XGEN(x)], 1u);
            asm volatile("s_waitcnt vmcnt(0)" ::: "memory");
        } else {
            XB_SPIN(xb_ld(&bar[XB_XGEN(x)]) == gen, bar);
            __builtin_amdgcn_fence(__ATOMIC_ACQUIRE, "agent");
            asm volatile("s_waitcnt vmcnt(0)" ::: "memory");
        }
    }
    __syncthreads();
}

__global__ void __launch_bounds__(NT, 2) fwd_mega(Params p) {
  extern __shared__ __attribute__((aligned(16))) unsigned char lds[];
  cg::grid_group grid = cg::this_grid();
  PG8_LAS unsigned char* lds3 = (PG8_LAS unsigned char*)lds;
  const int wave_s = __builtin_amdgcn_readfirstlane(threadIdx.x >> 6);
  volatile LAS unsigned* bst = (volatile LAS unsigned*)((LAS unsigned char*)lds + LDS_MISC);
  if (threadIdx.x < 2) bst[threadIdx.x] = 0u;
  build_bias_tables((char*)lds, wave_s);
  ph_prologue((float*)lds, wave_s);
  if (KWS() == nullptr) grid.sync();
  xcd_barrier_post(WSP(unsigned, W_BAR), wave_s);
  xcd_barrier(WSP(unsigned, W_BAR), bst, wave_s);
#ifndef PROBE_SUB
#define PROBE_SUB -99
#endif
#pragma unroll 1
  for (int ph = 0; ph < DEPTH * 5; ++ph) {
    const int li = ph / 5, sub = ph % 5 + 1;
#pragma unroll 1
    for (int rep = 0; rep < ((sub == PROBE_SUB && (sub != 5 || li == 0 || li == DEPTH - 1)) ? 2 : 1); ++rep) {
    if (sub == 1 || sub == 3 || sub == 4) {
      pg8::Gemm g; pg8::EpiMulti E; int extra = 0;
      if (sub == 1) { g = pg8::Gemm{WSP(bf16_t, W_XA), WIN_L(li), MPAD, INW, DM}; E = pg8::EpiMulti{1, li}; extra = (li == 0) ? 32 : 0; }
      else if (sub == 3) { g = pg8::Gemm{WSP(bf16_t, W_CACT), WSP(bf16_t, W_WPW) + (size_t)li * CCH * CCH, MPAD, CCH, CCH}; E = pg8::EpiMulti{3, li}; }
      else { g = pg8::Gemm{WSP(bf16_t, W_MIX), WSP(bf16_t, W_WOUT) + (size_t)li * DM * MIXW, MPAD, DM, MIXW}; E = pg8::EpiMulti{2, li}; }
      int bid_ = blockIdx.x; asm volatile("" : "+s"(bid_)); int nb_ = gridDim.x; asm volatile("" : "+s"(nb_));
      pg8::StaticOrder S; S.init(g.M, g.N, nb_, bid_, extra);
      pg8::gemm_phase<pg8::EpiMulti, pg8::StaticOrder, true, true>(lds3, g, S, E, wave_s);
      if (sub == 1 || sub == 4) {
        const int nwgA = (MPAD / 256) * (INW / 256) + ((li == 0) ? 32 : 0), nwgC = (MPAD / 256) * (DM / 256);
        const int firstA = nwgA - (nwgA - 1) / nb_ * nb_, firstC = nwgC - (nwgC - 1) / nb_ * nb_;
        const int nslot = ((nb_ - firstA) + (nb_ - firstC)) * 8;
        const int first = (sub == 1) ? firstA : firstC;
        if (bid_ >= first) ph_filler(li, ((sub == 1) ? 0 : (nb_ - firstA) * 8) + (bid_ - first) * 8 + wave_s, 1, nslot, (float*)lds, wave_s);
      }
    }
    if (sub == 2) { ph_conv_tiles(li, (char*)lds, wave_s); ph_attn1(li, (char*)lds, wave_s); }
    else if (sub == 3) ph_attn2(li, (char*)lds, wave_s);
    else if (sub == 5) ph_postpre(li, wave_s);
    if (ph < DEPTH * 5 - 1) xcd_barrier(WSP(unsigned, W_BAR), bst, wave_s);
    }
  }
}

extern "C" void kernel_launch(void* const* d_in, const int* in_sizes, int n_in, void* d_out, int out_size, void* d_ws, size_t ws_size, hipStream_t stream) {
  static int grid_blocks = 0;
  if (!grid_blocks) {
    int dev = 0, cus = 0, per_cu = 0;
    (void)hipGetDevice(&dev);
    (void)hipDeviceGetAttribute(&cus, hipDeviceAttributeMultiprocessorCount, dev);
    (void)hipFuncSetAttribute((const void*)fwd_mega, hipFuncAttributeMaxDynamicSharedMemorySize, LDS_BYTES);
    (void)hipOccupancyMaxActiveBlocksPerMultiprocessor(&per_cu, (const void*)fwd_mega, NT, LDS_BYTES);
    if (per_cu < 1) { fprintf(stderr, "occupancy query returned %d\n", per_cu); per_cu = 1; }
    grid_blocks = cus * per_cu;
    if (ws_size < W_END) fprintf(stderr, "workspace too small: %zu < %zu\n", ws_size, (size_t)W_END);
  }
  (void)hipMemsetAsync((unsigned char*)d_ws + W_BAR, 0, 16384, stream);
  Params p{};
  for (int i = 0; i < 19; ++i) p.in[i] = (const float*)d_in[i];
  p.out = (float*)d_out; p.ws = (unsigned char*)d_ws;
  void* args[] = {&p};
  hipError_t e = hipLaunchCooperativeKernel((const void*)fwd_mega, dim3(grid_blocks), dim3(NT), args, LDS_BYTES, stream);
  if (e != hipSuccess) fprintf(stderr, "cooperative launch failed: %s (grid %d)\n", hipGetErrorString(e), grid_blocks);
}
```
